# Optimizing an MI355X kernel written in HIP

```python
import math
import jax
import jax.numpy as jnp
from jax import lax
import numpy as np

D_MODEL = 1024
BATCH = 16
SEQ = 256
DEPTH = 2
DEC_BATCH = 8
DEC_SEQ = 1024
PAST_LEN = 256

GRID_W = 64
N_BRANCH = 4
MIX_W = 256
H_A = 4
NOPE_A = 64
ROPE_A = 32
VH_A = 64
Q_LORA = 256
KV_LORA = 128
D_B = 256
G_B = 4
CHUNK_B = 128
H_C = 4
DH_C = 64
D_C = H_C * DH_C
CHUNK_C = 64
H_D = 4
DH_D = 32
D_D = H_D * 2 * DH_D
D_FF = 4 * D_MODEL
IN_A = Q_LORA + KV_LORA + ROPE_A
IN_B = 2 * D_B
IN_C = 4 * D_C + 4 * H_C
IN_D = 3 * D_D
IN_W = IN_A + IN_B + IN_C + IN_D
ROPE_BASE = 10000.0
EPS = 1e-6
MLA_SCALE = (NOPE_A + ROPE_A) ** -0.5
DIFF_SCALE = DH_D ** -0.5
DENSE_MAX_KEYS = 2048
Q_BLOCK = 128

kernel_name = "hybrid_diffusion_mla_gmlp_mlstm_diffattn_step"


def _rms(x, g):
    xf = x.astype(jnp.float32)
    y = xf * lax.rsqrt(jnp.mean(xf * xf, axis=-1, keepdims=True) + EPS)
    return (y * g.astype(jnp.float32)).astype(x.dtype)


def _axial_tables(rows, dim):
    row = jnp.repeat(jnp.arange(rows), GRID_W).astype(jnp.float32)
    col = jnp.tile(jnp.arange(GRID_W), rows).astype(jnp.float32)
    nf = dim // 4
    inv = jnp.exp(-math.log(ROPE_BASE) * jnp.arange(nf, dtype=jnp.float32) / nf)
    ang = jnp.concatenate([row[:, None] * inv, col[:, None] * inv], axis=-1)
    return jnp.cos(ang), jnp.sin(ang)


def _rope(x, cos, sin):
    half = x.shape[-1] // 2
    xf = x.astype(jnp.float32)
    x1, x2 = xf[..., :half], xf[..., half:]
    c = cos[None, :, None, :]
    s = sin[None, :, None, :]
    return jnp.concatenate([x1 * c - x2 * s, x1 * s + x2 * c], axis=-1).astype(x.dtype)


def _attend(q, k, v, scale):
    def block(qb):
        s = jnp.einsum('bqhd,bkhd->bhqk', qb, k).astype(jnp.float32) * scale
        p = jax.nn.softmax(s, axis=-1).astype(v.dtype)
        return jnp.einsum('bhqk,bkhe->bqhe', p, v)
    B, Lq = q.shape[0], q.shape[1]
    if k.shape[1] < DENSE_MAX_KEYS or Lq % Q_BLOCK != 0:
        return block(q)
    qb = q.reshape(B, Lq // Q_BLOCK, Q_BLOCK, *q.shape[2:]).swapaxes(0, 1)
    out = lax.map(block, qb)
    return out.swapaxes(0, 1).reshape(B, Lq, *out.shape[3:])


def _mla(z, q_norm, w_uq, kv_norm, w_ukv, rope_cs, ctx_ckv, ctx_kr):
    B, L, _ = z.shape
    cq = _rms(z[..., :Q_LORA], q_norm)
    ckv = _rms(z[..., Q_LORA:Q_LORA + KV_LORA], kv_norm)
    kr = z[..., Q_LORA + KV_LORA:IN_A]
    qh = (cq @ w_uq).reshape(B, L, H_A, NOPE_A + ROPE_A)
    q_nope, q_rope = qh[..., :NOPE_A], qh[..., NOPE_A:]
    if rope_cs is None:
        ckv_all, kr_all = ckv, kr
    else:
        cos, sin = rope_cs
        q_rope = _rope(q_rope, cos, sin)
        kr_lat = _rope(kr[:, :, None, :], cos, sin)[:, :, 0]
        ckv_all = jnp.concatenate([ctx_ckv.astype(ckv.dtype), ckv], axis=1)
        kr_all = jnp.concatenate([ctx_kr.astype(kr.dtype), kr_lat], axis=1)
    Lk = ckv_all.shape[1]
    kv = (ckv_all @ w_ukv).reshape(B, Lk, H_A, NOPE_A + VH_A)
    k = jnp.concatenate([kv[..., :NOPE_A], jnp.broadcast_to(kr_all[:, :, None, :], (B, Lk, H_A, ROPE_A))], axis=-1)
    q = jnp.concatenate([q_nope, q_rope], axis=-1)
    out = _attend(q, k, kv[..., NOPE_A:], MLA_SCALE)
    return out.reshape(B, L, H_A * VH_A), ckv, kr


def _chunk_mlp(z, v_norm, w_s, b_s):
    B, L, _ = z.shape
    u = z[..., :D_B]
    v = _rms(z[..., D_B:], v_norm)
    vc = v.reshape(B, L // CHUNK_B, CHUNK_B, G_B, D_B // G_B)
    mixed = jnp.einsum('gpq,bnqgd->bnpgd', w_s, vc) + b_s.T[None, None, :, :, None]
    return u * mixed.reshape(B, L, D_B)


def _mlstm_dir(q, k, v, i_pre, f_pre, state):
    B, H, L, _ = q.shape
    nc = L // CHUNK_C

    def chunks(a):
        return jnp.moveaxis(a.reshape(B, H, nc, CHUNK_C, *a.shape[3:]), 2, 0)

    tril = jnp.tril(jnp.ones((CHUNK_C, CHUNK_C), dtype=bool))

    def step(carry, xs):
        C, n, m = carry
        qc, kc, vc, ic, lfc = xs
        b = jnp.cumsum(lfc, axis=-1)
        d_log = jnp.where(tril, b[..., :, None] - b[..., None, :] + ic[..., None, :], -jnp.inf)
        inter = b + m[..., None]
        mt = jnp.maximum(inter, jnp.max(d_log, axis=-1))
        w_inter = jnp.exp(inter - mt)
        s = jnp.einsum('bhtd,bhsd->bhts', qc, kc) * jnp.exp(d_log - mt[..., None])
        num = w_inter[..., None] * jnp.einsum('bhtd,bhde->bhte', qc, C) + jnp.einsum('bhts,bhse->bhte', s, vc)
        den = w_inter * jnp.einsum('bhtd,bhd->bht', qc, n) + jnp.sum(s, axis=-1)
        hc = num / jnp.maximum(jnp.abs(den), jnp.exp(-mt))[..., None]
        bT = b[..., -1]
        a_s = bT[..., None] - b + ic
        m_new = jnp.maximum(bT + m, jnp.max(a_s, axis=-1))
        w_old = jnp.exp(bT + m - m_new)
        w_s = jnp.exp(a_s - m_new[..., None])
        C_new = w_old[..., None, None] * C + jnp.einsum('bhs,bhsd,bhse->bhde', w_s, kc, vc)
        n_new = w_old[..., None] * n + jnp.einsum('bhs,bhsd->bhd', w_s, kc)
        return (C_new, n_new, m_new), hc

    xs = (chunks(q), chunks(k), chunks(v), chunks(i_pre), chunks(jax.nn.log_sigmoid(f_pre)))
    state, hs = lax.scan(step, state, xs)
    h = jnp.moveaxis(hs, 0, 2).reshape(B, H, L, v.shape[-1])
    return h, state


def _mlstm(z, gate_bias, head_norm, state):
    B, L, _ = z.shape

    def heads(a):
        return a.reshape(B, L, H_C, DH_C).transpose(0, 2, 1, 3).astype(jnp.float32)

    q = heads(z[..., :D_C])
    k = heads(z[..., D_C:2 * D_C]) * (DH_C ** -0.5)
    v = heads(z[..., 2 * D_C:3 * D_C])
    o = z[..., 3 * D_C:4 * D_C]
    g = (z[..., 4 * D_C:IN_C].reshape(B, L, 2, 2, H_C) + gate_bias).astype(jnp.float32)
    g = g.transpose(2, 3, 0, 4, 1)
    C0, n0, m0 = state
    st0_fw = (C0[:, 0].astype(jnp.float32), n0[:, 0].astype(jnp.float32), m0[:, 0].astype(jnp.float32))
    st0_bw = (C0[:, 1].astype(jnp.float32), n0[:, 1].astype(jnp.float32), m0[:, 1].astype(jnp.float32))
    flip = lambda a: jnp.flip(a, axis=2)
    h_fw, st_fw = _mlstm_dir(q, k, v, g[0, 0], g[0, 1], st0_fw)
    h_bw, st_bw = _mlstm_dir(flip(q), flip(k), flip(v), flip(g[1, 0]), flip(g[1, 1]), st0_bw)
    h = (h_fw + flip(h_bw)).transpose(0, 2, 1, 3)
    h = _rms(h, head_norm.reshape(H_C, DH_C)).reshape(B, L, D_C)
    out = (jax.nn.sigmoid(o.astype(jnp.float32)) * h).astype(z.dtype)
    new_C = jnp.stack([st_fw[0], st_bw[0]], axis=1)
    new_n = jnp.stack([st_fw[1], st_bw[1]], axis=1)
    new_m = jnp.stack([st_fw[2], st_bw[2]], axis=1)
    return out, (new_C, new_n, new_m)


def _diff_attn(z, lam, sub_norm, lam_init, rope_cs, ctx_k, ctx_v):
    B, L, _ = z.shape
    q = z[..., :D_D].reshape(B, L, H_D, 2, DH_D)
    k = z[..., D_D:2 * D_D].reshape(B, L, H_D, 2, DH_D)
    v = z[..., 2 * D_D:3 * D_D].reshape(B, L, H_D, 2 * DH_D)
    if rope_cs is None:
        q_use, k_all, v_all = q, k, v
    else:
        cos, sin = rope_cs
        q_use = _rope(q.reshape(B, L, 2 * H_D, DH_D), cos, sin).reshape(B, L, H_D, 2, DH_D)
        k_rot = _rope(k.reshape(B, L, 2 * H_D, DH_D), cos, sin).reshape(B, L, H_D, 2, DH_D)
        k_all = jnp.concatenate([ctx_k.astype(k.dtype), k_rot], axis=1)
        v_all = jnp.concatenate([ctx_v.astype(v.dtype), v], axis=1)
    lf = lam.astype(jnp.float32)
    lam_val = jnp.exp(jnp.sum(lf[0] * lf[1])) - jnp.exp(jnp.sum(lf[2] * lf[3])) + lam_init
    o1 = _attend(q_use[:, :, :, 0], k_all[:, :, :, 0], v_all, DIFF_SCALE).astype(jnp.float32)
    o2 = _attend(q_use[:, :, :, 1], k_all[:, :, :, 1], v_all, DIFF_SCALE).astype(jnp.float32)
    o = _rms(o1 - lam_val * o2, sub_norm) * (1.0 - lam_init)
    return o.reshape(B, L, D_D).astype(z.dtype), k, v


def _trunk_layer(x, cond, rope_cs, ctx, l, w_mod, b_mod, norm_g, w_in, mla_q_norm, w_uq, mla_kv_norm, w_ukv,
                 gmlp_v_norm, gmlp_w_s, gmlp_b_s, mlstm_gate_bias, mlstm_head_norm, diff_lambda, diff_sub_norm,
                 w_branch, w_merge, b_merge, w_out, w_ff1, w_ff2):
    B, L, _ = x.shape
    mod = (jax.nn.silu(cond) @ w_mod[l] + b_mod[l])[:, None, :]
    sh1, sc1, g1, sh2, sc2, g2 = jnp.split(mod, 6, axis=-1)
    h = _rms(x, norm_g[l, 0]) * (1.0 + sc1) + sh1
    z = h @ w_in[l]
    za = z[..., :IN_A]
    zb = z[..., IN_A:IN_A + IN_B]
    zc = z[..., IN_A + IN_B:IN_A + IN_B + IN_C]
    zd = z[..., IN_A + IN_B + IN_C:]
    if ctx is None:
        ctx_ckv = ctx_kr = ctx_k = ctx_v = None
        st0 = (jnp.zeros((B, 2, H_C, DH_C, DH_C), jnp.float32), jnp.zeros((B, 2, H_C, DH_C), jnp.float32),
               jnp.zeros((B, 2, H_C), jnp.float32))
        rope_a = rope_d = None
    else:
        ctx_ckv, ctx_kr, ctx_k, ctx_v, sC, sn, sm = ctx
        st0 = (sC, sn, sm)
        rope_a, rope_d = rope_cs
    lam_init = 0.8 - 0.6 * math.exp(-0.3 * l)
    ya, ckv, kr = _mla(za, mla_q_norm[l], w_uq[l], mla_kv_norm[l], w_ukv[l], rope_a, ctx_ckv, ctx_kr)
    yb = _chunk_mlp(zb, gmlp_v_norm[l], gmlp_w_s[l], gmlp_b_s[l])
    yc, st = _mlstm(zc, mlstm_gate_bias[l], mlstm_head_norm[l], st0)
    yd, kd, vd = _diff_attn(zd, diff_lambda[l], diff_sub_norm[l], lam_init, rope_d, ctx_k, ctx_v)
    br = jnp.einsum('blnw,nwd->blnd', jnp.stack([ya, yb, yc, yd], axis=2), w_branch[l])
    gates = jax.nn.sigmoid(h @ w_merge[l] + b_merge[l]).reshape(B, L, N_BRANCH, D_MODEL)
    y = jnp.sum(gates * br, axis=2) @ w_out[l]
    x = x + g1 * _rms(y, norm_g[l, 1])
    h2 = _rms(x, norm_g[l, 2]) * (1.0 + sc2) + sh2
    f = jnp.square(jax.nn.relu(h2 @ w_ff1[l])) @ w_ff2[l]
    x = x + g2 * _rms(f, norm_g[l, 3])
    if ctx is None:
        return x, (ckv, kr, kd, vd, st[0], st[1], st[2])
    return x, None


def setup_inputs(seed: int = 0) -> dict:
    key = jax.random.key(seed)
    ks = jax.random.split(key, 40)
    f32 = jnp.float32

    def nrm(i, shape, scale):
        return jax.random.normal(ks[i], shape, f32) * scale

    def gain(i, shape):
        return 1.0 + nrm(i, shape, 0.05)

    gate_bias = nrm(16, (DEPTH, 2, 2, H_C), 0.1) + jnp.array([0.0, 3.0], f32)[None, None, :, None]
    return {
        "x_prompt": nrm(0, (BATCH, SEQ, D_MODEL), 1.0),
        "x_sample": nrm(1, (DEC_BATCH, DEC_SEQ, D_MODEL), 1.0),
        "cache_mla_ckv": nrm(2, (DEC_BATCH, DEPTH, PAST_LEN, KV_LORA), 1.0),
        "cache_mla_krope": nrm(3, (DEC_BATCH, DEPTH, PAST_LEN, ROPE_A), 1.0),
        "cache_diff_k": nrm(4, (DEC_BATCH, DEPTH, PAST_LEN, H_D, 2, DH_D), 1.0),
        "cache_diff_v": nrm(5, (DEC_BATCH, DEPTH, PAST_LEN, H_D, 2 * DH_D), 1.0),
        "state_mlstm_C": nrm(6, (DEC_BATCH, DEPTH, 2, H_C, DH_C, DH_C), 0.5),
        "state_mlstm_n": nrm(7, (DEC_BATCH, DEPTH, 2, H_C, DH_C), 0.5),
        "state_mlstm_m": nrm(8, (DEC_BATCH, DEPTH, 2, H_C), 0.5),
        "c": nrm(9, (DEC_BATCH, D_MODEL), 1.0),
        "c_ctx": nrm(10, (D_MODEL,), 1.0),
        "w_mod": nrm(11, (DEPTH, D_MODEL, 6 * D_MODEL), 0.5 * D_MODEL ** -0.5),
        "b_mod": nrm(12, (DEPTH, 6 * D_MODEL), 0.02),
        "norm_g": gain(13, (DEPTH, 4, D_MODEL)),
        "w_in": nrm(14, (DEPTH, D_MODEL, IN_W), D_MODEL ** -0.5),
        "mla_q_norm": gain(15, (DEPTH, Q_LORA)),
        "w_uq": nrm(17, (DEPTH, Q_LORA, H_A * (NOPE_A + ROPE_A)), Q_LORA ** -0.5),
        "mla_kv_norm": gain(18, (DEPTH, KV_LORA)),
        "w_ukv": nrm(19, (DEPTH, KV_LORA, H_A * (NOPE_A + VH_A)), KV_LORA ** -0.5),
        "gmlp_v_norm": gain(20, (DEPTH, D_B)),
        "gmlp_w_s": nrm(21, (DEPTH, G_B, CHUNK_B, CHUNK_B), CHUNK_B ** -0.5),
        "gmlp_b_s": 1.0 + nrm(22, (DEPTH, G_B, CHUNK_B), 0.05),
        "mlstm_gate_bias": gate_bias,
        "mlstm_head_norm": gain(23, (DEPTH, D_C)),
        "diff_lambda": nrm(24, (DEPTH, 4, DH_D), 0.1),
        "diff_sub_norm": gain(25, (DEPTH, 2 * DH_D)),
        "w_branch": nrm(26, (DEPTH, N_BRANCH, MIX_W, D_MODEL), MIX_W ** -0.5),
        "w_merge": nrm(27, (DEPTH, D_MODEL, N_BRANCH * D_MODEL), D_MODEL ** -0.5),
        "b_merge": nrm(28, (DEPTH, N_BRANCH * D_MODEL), 0.02),
        "w_out": nrm(29, (DEPTH, D_MODEL, D_MODEL), D_MODEL ** -0.5),
        "w_ff1": nrm(30, (DEPTH, D_MODEL, D_FF), D_MODEL ** -0.5),
        "w_ff2": nrm(31, (DEPTH, D_FF, D_MODEL), D_FF ** -0.5),
    }


def reference(x_prompt, x_sample, cache_mla_ckv, cache_mla_krope, cache_diff_k, cache_diff_v,
              state_mlstm_C, state_mlstm_n, state_mlstm_m, c, c_ctx, w_mod, b_mod, norm_g, w_in,
              mla_q_norm, w_uq, mla_kv_norm, w_ukv, gmlp_v_norm, gmlp_w_s, gmlp_b_s, mlstm_gate_bias,
              mlstm_head_norm, diff_lambda, diff_sub_norm, w_branch, w_merge, b_merge, w_out, w_ff1, w_ff2):
    weights = (w_mod, b_mod, norm_g, w_in, mla_q_norm, w_uq, mla_kv_norm, w_ukv, gmlp_v_norm, gmlp_w_s,
               gmlp_b_s, mlstm_gate_bias, mlstm_head_norm, diff_lambda, diff_sub_norm, w_branch, w_merge,
               b_merge, w_out, w_ff1, w_ff2)
    xp = x_prompt
    ents = []
    for l in range(DEPTH):
        xp, ent = _trunk_layer(xp, c_ctx[None, :], None, None, l, *weights)
        ents.append(ent)
    new_mla_ckv = jnp.stack([e[0] for e in ents], axis=1)
    new_mla_krope = jnp.stack([e[1] for e in ents], axis=1)
    new_diff_k = jnp.stack([e[2] for e in ents], axis=1)
    new_diff_v = jnp.stack([e[3] for e in ents], axis=1)
    new_mlstm_C = jnp.stack([e[4] for e in ents], axis=1)
    new_mlstm_n = jnp.stack([e[5] for e in ents], axis=1)
    new_mlstm_m = jnp.stack([e[6] for e in ents], axis=1)
    rows = x_sample.shape[1] // GRID_W
    rope_cs = (_axial_tables(rows, ROPE_A), _axial_tables(rows, DH_D))
    xs = x_sample
    for l in range(DEPTH):
        ctx = (cache_mla_ckv[:, l], cache_mla_krope[:, l], cache_diff_k[:, l], cache_diff_v[:, l],
               state_mlstm_C[:, l], state_mlstm_n[:, l], state_mlstm_m[:, l])
        xs, _ = _trunk_layer(xs, c, rope_cs, ctx, l, *weights)
    return (xp, xs, new_mla_ckv, new_mla_krope, new_diff_k, new_diff_v, new_mlstm_C, new_mlstm_n, new_mlstm_m)
```

```cpp
#include <hip/hip_runtime.h>
#include <hip/hip_cooperative_groups.h>
#include <cstdio>
#include <cstdint>
namespace cg = cooperative_groups;

#ifndef MEGA
#define MEGA 1
#endif
#ifndef DUPMASK
#define DUPMASK 0u
#endif

#define DI __device__ __forceinline__
typedef unsigned short u16;
typedef __attribute__((ext_vector_type(8))) short bf16x8;
typedef __attribute__((ext_vector_type(4))) short s16x4;
typedef __attribute__((ext_vector_type(16))) float f32x16;
typedef __attribute__((ext_vector_type(2))) __bf16 bf2_t;
typedef __attribute__((ext_vector_type(4))) unsigned u32x4;
typedef __attribute__((ext_vector_type(2))) unsigned u32x2;
#define MFMA32(a, b, c) __builtin_amdgcn_mfma_f32_32x32x16_bf16((a), (b), (c), 0, 0, 0)

constexpr int D = 1024, TC = 4096, TL = 8192, T = 12288, KEYROWS = 14336;
constexpr int ZLD = 2736;
constexpr int ZB = 416, ZC = 928, ZD = 1968;
constexpr int NWIN = 2816;
constexpr int LDH = 1088, LDU = 4160;
constexpr float EPS = 1e-6f;
constexpr float LOG2E = 1.4426950408889634f;
constexpr int NCHUNK = 192;

constexpr size_t O_YP = 0, O_YS = 4194304, O_CKV = 12582912, O_KR = 13631488, O_DK = 13893632, O_DV = 15990784,
                 O_C = 18087936, O_N = 19136512, O_M = 19152896;

constexpr size_t WB_IN = 0;
constexpr size_t WB_MG = WB_IN + (size_t)NWIN * LDH;
constexpr size_t WB_UQ = WB_MG + (size_t)4096 * LDH;
constexpr size_t WB_UKV = WB_UQ + (size_t)384 * 256;
constexpr size_t WB_BR = WB_UKV + (size_t)512 * 128;
constexpr size_t WB_OUT = WB_BR + (size_t)4 * 1024 * 256;
constexpr size_t WB_FF1 = WB_OUT + (size_t)1024 * LDH;
constexpr size_t WB_FF2 = WB_FF1 + (size_t)4096 * LDH;
constexpr size_t WB_WS = WB_FF2 + (size_t)1024 * LDU;
constexpr size_t WB_TOTAL = WB_WS + (size_t)4 * 128 * 128;

constexpr size_t al256(size_t x) { return (x + 255) & ~(size_t)255; }
constexpr size_t WS_WB = 0;
constexpr size_t WS_H = al256(WS_WB + WB_TOTAL * 2);
constexpr size_t WS_R1 = al256(WS_H + (size_t)T * LDH * 2);
constexpr size_t R1_Z = 0;
constexpr size_t R1_YMIX = al256((size_t)T * ZLD * 2);
constexpr size_t R1_SIZE = (size_t)T * LDU * 2;
static_assert(R1_YMIX + (size_t)T * LDH * 2 <= R1_SIZE, "R1 overflow");
constexpr size_t WS_R2 = al256(WS_R1 + R1_SIZE);
constexpr size_t R2_CQ = 0;
constexpr size_t R2_QMLA = al256(R2_CQ + (size_t)T * 256 * 2);
constexpr size_t R2_CKV = al256(R2_QMLA + (size_t)T * 384 * 2);
constexpr size_t R2_KMLA = al256(R2_CKV + (size_t)KEYROWS * 128 * 2);
constexpr size_t R2_VMLA = al256(R2_KMLA + (size_t)KEYROWS * 384 * 2);
constexpr size_t R2_END = al256(R2_VMLA + (size_t)KEYROWS * 256 * 2);
constexpr size_t R2_G3 = al256((size_t)T * LDH * 2);
constexpr size_t R2_SIZE = R2_G3 + (size_t)T * 1024 * 2;
static_assert(R2_END <= R2_SIZE, "R2 overflow");
constexpr size_t WS_R3 = al256(WS_R2 + R2_SIZE);
constexpr size_t R3_DC = 0;
constexpr size_t R3_DN = al256(R3_DC + (size_t)2 * 4 * NCHUNK * 4096 * 4);
constexpr size_t R3_CHB = al256(R3_DN + (size_t)2 * 4 * NCHUNK * 64 * 4);
constexpr size_t R3_CHM = al256(R3_CHB + (size_t)2 * 4 * NCHUNK * 4);
constexpr size_t R3_MST = al256(R3_CHM + (size_t)2 * 4 * NCHUNK * 4);
constexpr size_t R3_GATES = al256(R3_MST + (size_t)2 * 4 * NCHUNK * 4);
constexpr size_t R3_GB = al256(R3_GATES + (size_t)T * 16 * 4);
constexpr size_t R3_GI = al256(R3_GB + (size_t)8 * T * 4);
constexpr size_t R3_RSTDV = al256(R3_GI + (size_t)8 * T * 4);
constexpr size_t R3_MOD = al256(R3_RSTDV + (size_t)T * 4);
constexpr size_t R3_ROPE = al256(R3_MOD + (size_t)2 * 9 * 6144 * 4);
constexpr size_t R3_LAM = al256(R3_ROPE + (size_t)1024 * 16 * 8);
constexpr size_t R3_QD = al256(R3_LAM + 256);
constexpr size_t R3_KD = al256(R3_QD + (size_t)T * 256 * 2);
constexpr size_t R3_VD = al256(R3_KD + (size_t)KEYROWS * 256 * 2);
constexpr size_t R3_END = al256(R3_VD + (size_t)KEYROWS * 256 * 2);
constexpr size_t WS_BAR = WS_R3 + R3_END;
constexpr size_t BAR_BYTES = 16384;
constexpr size_t WS_TOTAL = WS_BAR + BAR_BYTES;
static_assert(WS_TOTAL <= (size_t)256 * 1024 * 1024, "workspace over 256 MiB");

struct Params {
  const float* in[32];
  float* out;
  char* ws;
};

constexpr int SMEM_BYTES = 2 * (192 + 128) * 128;

DI int tidx() { int t = __builtin_amdgcn_workitem_id_x(); asm volatile("" : "+v"(t)); return t; }
DI float bf2f(u16 v) { return __uint_as_float(((unsigned)v) << 16); }
DI unsigned pk2(float a, float b) { bf2_t v; v[0] = (__bf16)a; v[1] = (__bf16)b; return __builtin_bit_cast(unsigned, v); }
DI u16 f2bf(float a) { __bf16 v = (__bf16)a; return __builtin_bit_cast(u16, v); }
DI float wave_sum(float v) {
#pragma unroll
  for (int o = 32; o > 0; o >>= 1) v += __shfl_xor(v, o);
  return v;
}
DI float wave_max(float v) {
#pragma unroll
  for (int o = 32; o > 0; o >>= 1) v = fmaxf(v, __shfl_xor(v, o));
  return v;
}
DI float sigmoidf_(float x) { return 1.f / (1.f + __expf(-x)); }
DI int crow(int reg, int h) { return (reg & 3) + 8 * (reg >> 2) + 4 * h; }
DI void zero16(f32x16& a) {
#pragma unroll
  for (int i = 0; i < 16; ++i) a[i] = 0.f;
}
DI bf16x8 pack8(const f32x16& x, int s) {
  uint4 p;
  p.x = pk2(x[8 * s + 0], x[8 * s + 1]); p.y = pk2(x[8 * s + 2], x[8 * s + 3]);
  p.z = pk2(x[8 * s + 4], x[8 * s + 5]); p.w = pk2(x[8 * s + 6], x[8 * s + 7]);
  return __builtin_bit_cast(bf16x8, p);
}
DI float dpp_xor1(float v) { return __builtin_bit_cast(float, __builtin_amdgcn_update_dpp(0, __builtin_bit_cast(int, v), 0xB1, 0xF, 0xF, true)); }
DI float dpp_xor2(float v) { return __builtin_bit_cast(float, __builtin_amdgcn_update_dpp(0, __builtin_bit_cast(int, v), 0x4E, 0xF, 0xF, true)); }
DI void quad_tr(f32x16& a, int lane) {
  const bool o1 = lane & 1, o2 = lane & 2;
#pragma unroll
  for (int g = 0; g < 4; ++g) {
    float a0 = a[4 * g], a1 = a[4 * g + 1], a2 = a[4 * g + 2], a3 = a[4 * g + 3];
    float rv = dpp_xor1(o1 ? a0 : a1);
    if (o1) a0 = rv; else a1 = rv;
    rv = dpp_xor1(o1 ? a2 : a3);
    if (o1) a2 = rv; else a3 = rv;
    const float r0 = dpp_xor2(o2 ? a0 : a2), r1 = dpp_xor2(o2 ? a1 : a3);
    if (o2) { a0 = r0; a1 = r1; } else { a2 = r0; a3 = r1; }
    a[4 * g] = a0; a[4 * g + 1] = a1; a[4 * g + 2] = a2; a[4 * g + 3] = a3;
  }
}
DI int midx_of(int row) { return row < TC ? 0 : 1 + ((row - TC) >> 10); }
DI int keyrow_of(int row) { return row < TC ? row : TC + ((row - TC) >> 10) * 1280 + 256 + ((row - TC) & 1023); }

struct GNext { const u16* A; const u16* B; };
template <int TM, int BN>
DI void gemm_kloop(const u16* __restrict__ A, int lda, const u16* __restrict__ Bt, int ldb, int K, char* smem,
                   f32x16 (&acc)[TM][BN / 64], GNext nx = GNext{nullptr, nullptr}, bool* primed = nullptr) {
  constexpr int BM = 64 * TM, TN = BN / 64;
  constexpr int NA = BM / 32, NBI = BN / 32;
  constexpr int STGB = (BM + BN) * 128;
  const int tid = tidx(), lane = tid & 63, w = tid >> 6, wm = w >> 1, wn = w & 1, r = lane & 31, h = lane >> 5;
  const int gkc = ((tid & 7) ^ ((tid >> 4) & 7)) * 8;
  const u16* Ap = A + (size_t)(tid >> 3) * lda + gkc;
  const u16* Bp = Bt + (size_t)(tid >> 3) * ldb + gkc;
  const int nk = K >> 6;
  const bool hasnext = nx.A != nullptr;
  const u16* nAp = hasnext ? nx.A + (size_t)(tid >> 3) * lda + gkc : Ap;
  const u16* nBp = hasnext ? nx.B + (size_t)(tid >> 3) * ldb + gkc : Bp;
  auto issue_from = [&](const u16* ap, const u16* bp, int stg, int idx) {
    char* dst = smem + stg * STGB + tid * 16;
    if (idx < NA)
      __builtin_amdgcn_global_load_lds((const unsigned*)(ap + (size_t)(idx * 32) * lda), (__attribute__((address_space(3))) unsigned*)(dst + idx * 4096), 16, 0, 0);
    else
      __builtin_amdgcn_global_load_lds((const unsigned*)(bp + (size_t)((idx - NA) * 32) * ldb), (__attribute__((address_space(3))) unsigned*)(dst + BM * 128 + (idx - NA) * 4096), 16, 0, 0);
  };
  const int sw = (r >> 1) & 7;
  const unsigned lbase = (unsigned)(size_t)smem;
  const unsigned abase = lbase + (wm * (BM / 2) + r) * 128;
  const unsigned bbase = lbase + BM * 128 + (wn * (BN / 2) + r) * 128;
  if (!(primed && *primed)) {
    asm volatile("s_waitcnt vmcnt(0)" ::: "memory");
    __builtin_amdgcn_s_barrier();
#pragma unroll
    for (int i = 0; i < NA + NBI; ++i) issue_from(Ap, Bp, 0, i);
  }
  if (primed) *primed = hasnext;
  for (int kt = 0; kt < nk; ++kt) {
    asm volatile("s_waitcnt vmcnt(0)" ::: "memory");
    __builtin_amdgcn_s_barrier();
    const bool last = kt + 1 >= nk;
    const bool more = !last || hasnext;
    const u16* sAp = last ? nAp : Ap + (kt + 1) * 64;
    const u16* sBp = last ? nBp : Bp + (kt + 1) * 64;
    const unsigned so = (kt & 1) * STGB;
    bf16x8 af[2][2][TM], bfr[2][2][TN];
#pragma unroll
    for (int hf = 0; hf < 2; ++hf) {
#pragma unroll
      for (int kk = 0; kk < 2; ++kk) {
        const unsigned co = (((hf * 2 + kk) * 2 + h) ^ sw) * 16 + so;
#pragma unroll
        for (int i = 0; i < TM; ++i) asm volatile("ds_read_b128 %0, %1" : "=v"(af[hf][kk][i]) : "v"(abase + co + i * 4096));
#pragma unroll
        for (int j = 0; j < TN; ++j) asm volatile("ds_read_b128 %0, %1" : "=v"(bfr[hf][kk][j]) : "v"(bbase + co + j * 4096));
      }
    }
    asm volatile("s_waitcnt lgkmcnt(%0)" ::"n"(2 * (TM + TN)) : "memory");
#pragma unroll
    for (int kk = 0; kk < 2; ++kk) {
#pragma unroll
      for (int i = 0; i < TM; ++i) asm volatile("" : "+v"(af[0][kk][i]));
#pragma unroll
      for (int j = 0; j < TN; ++j) asm volatile("" : "+v"(bfr[0][kk][j]));
    }
    __builtin_amdgcn_s_setprio(1);
#pragma unroll
    for (int kk = 0; kk < 2; ++kk)
#pragma unroll
      for (int i = 0; i < TM; ++i)
#pragma unroll
        for (int j = 0; j < TN; ++j) {
          acc[i][j] = MFMA32(af[0][kk][i], bfr[0][kk][j], acc[i][j]);
          constexpr int dummy = 0; (void)dummy;
          const int m = (kk * TM + i) * TN + j;
          if (m < NA + NBI) {
            __builtin_amdgcn_sched_barrier(0);
            if (more) issue_from(sAp, sBp, (kt + 1) & 1, m);
            __builtin_amdgcn_sched_barrier(0);
          }
        }
    if (more) {
#pragma unroll
      for (int m = 2 * TM * TN; m < NA + NBI; ++m) issue_from(sAp, sBp, (kt + 1) & 1, m);
    }
    asm volatile("s_waitcnt lgkmcnt(0)" ::: "memory");
#pragma unroll
    for (int kk = 0; kk < 2; ++kk) {
#pragma unroll
      for (int i = 0; i < TM; ++i) asm volatile("" : "+v"(af[1][kk][i]));
#pragma unroll
      for (int j = 0; j < TN; ++j) asm volatile("" : "+v"(bfr[1][kk][j]));
    }
#pragma unroll
    for (int kk = 0; kk < 2; ++kk)
#pragma unroll
      for (int i = 0; i < TM; ++i)
#pragma unroll
        for (int j = 0; j < TN; ++j) acc[i][j] = MFMA32(af[1][kk][i], bfr[1][kk][j], acc[i][j]);
    __builtin_amdgcn_s_setprio(0);
  }
}

template <int TM, int BN, class F>
DI void epi_each(f32x16 (&acc)[TM][BN / 64], int m0, int n0, F f) {
  const int w = tidx() >> 6, wm = w >> 1, wn = w & 1;
#pragma unroll
  for (int i = 0; i < TM; ++i)
#pragma unroll
    for (int j = 0; j < BN / 64; ++j) f(acc[i][j], m0 + wm * (32 * TM) + i * 32, n0 + wn * (BN / 2) + j * 32);
}
template <int TM, int TN>
DI void zero_acc(f32x16 (&acc)[TM][TN]) {
#pragma unroll
  for (int i = 0; i < TM; ++i)
#pragma unroll
    for (int j = 0; j < TN; ++j) zero16(acc[i][j]);
}
template <class F>
DI void for_tiles(int NM, int NN, int bid, int nb, F f) {
  if ((nb & 7) == 0 && (NM & 7) == 0) {
    const int x = bid & 7, ns = nb >> 3, tot = (NM >> 3) * NN;
    const int nmx = NM >> 3;
    for (int j = bid >> 3; j < tot; j += ns) {
      const int jn = j + ns;
      f((j % nmx) * 8 + x, j / nmx, jn < tot, (jn % nmx) * 8 + x, jn / nmx);
    }
  } else {
    for (int it = bid; it < NM * NN; it += nb) { const int itn = it + nb; f(it / NN, it % NN, itn < NM * NN, itn / NN, itn % NN); }
  }
}

DI bool tjob(int& t, int K, int N, int Npad, int ldd, const float* __restrict__ src, u16* __restrict__ dst, char* smem) {
  const int tk = K / 64, tn = Npad / 64;
  if (t >= tk * tn) { t -= tk * tn; return false; }
  float* tile = (float*)smem;
  const int k0 = (t / tn) * 64, n0 = (t % tn) * 64;
  const int tid = tidx();
  __syncthreads();
#pragma unroll
  for (int i = 0; i < 4; ++i) {
    const int k = i * 16 + (tid >> 4), n = n0 + (tid & 15) * 4;
    float4 v = make_float4(0.f, 0.f, 0.f, 0.f);
    if (n + 3 < N) v = *(const float4*)(src + (size_t)(k0 + k) * N + n);
    else {
      if (n < N) v.x = src[(size_t)(k0 + k) * N + n];
      if (n + 1 < N) v.y = src[(size_t)(k0 + k) * N + n + 1];
      if (n + 2 < N) v.z = src[(size_t)(k0 + k) * N + n + 2];
    }
    float* tp = tile + k * 65 + (tid & 15) * 4;
    tp[0] = v.x; tp[1] = v.y; tp[2] = v.z; tp[3] = v.w;
  }
  __syncthreads();
#pragma unroll
  for (int i = 0; i < 2; ++i) {
    const int n = i * 32 + (tid >> 3), kc = (tid & 7) * 8;
    uint4 o;
    o.x = pk2(tile[(kc + 0) * 65 + n], tile[(kc + 1) * 65 + n]);
    o.y = pk2(tile[(kc + 2) * 65 + n], tile[(kc + 3) * 65 + n]);
    o.z = pk2(tile[(kc + 4) * 65 + n], tile[(kc + 5) * 65 + n]);
    o.w = pk2(tile[(kc + 6) * 65 + n], tile[(kc + 7) * 65 + n]);
    *(uint4*)(dst + (size_t)(n0 + n) * ldd + k0 + kc) = o;
  }
  return true;
}
constexpr int CONV_ITEMS = 16 * 44 + 16 * 64 + 4 * 6 + 2 * 8 + 4 * 4 * 16 + 16 * 16 + 16 * 64 + 64 * 16 + 16;
DI void convert_item(const Params& p, int l, int t, char* smem) {
  u16* wb = (u16*)(p.ws + WS_WB);
  if (tjob(t, 1024, 2736, NWIN, LDH, p.in[14] + (size_t)l * 1024 * 2736, wb + WB_IN, smem)) return;
  if (tjob(t, 1024, 4096, 4096, LDH, p.in[27] + (size_t)l * 1024 * 4096, wb + WB_MG, smem)) return;
  if (tjob(t, 256, 384, 384, 256, p.in[16] + (size_t)l * 256 * 384, wb + WB_UQ, smem)) return;
  if (tjob(t, 128, 512, 512, 128, p.in[18] + (size_t)l * 128 * 512, wb + WB_UKV, smem)) return;
#pragma unroll 1
  for (int n = 0; n < 4; ++n)
    if (tjob(t, 256, 1024, 1024, 256, p.in[26] + ((size_t)l * 4 + n) * 256 * 1024, wb + WB_BR + (size_t)n * 1024 * 256, smem)) return;
  if (tjob(t, 1024, 1024, 1024, LDH, p.in[29] + (size_t)l * 1024 * 1024, wb + WB_OUT, smem)) return;
  if (tjob(t, 1024, 4096, 4096, LDH, p.in[30] + (size_t)l * 1024 * 4096, wb + WB_FF1, smem)) return;
  if (tjob(t, 4096, 1024, 1024, LDU, p.in[31] + (size_t)l * 4096 * 1024, wb + WB_FF2, smem)) return;
  const float* src = p.in[20] + (size_t)l * 65536 + (size_t)t * 4096;
  u16* dst = wb + WB_WS + (size_t)t * 4096;
  for (int i = tidx(); i < 4096; i += 256) dst[i] = f2bf(src[i]);
}

DI void mod_item(const Params& p, int it, char* smem) {
  const int l = it / 768, rem = it % 768, cb = rem >> 3, kp = rem & 7;
  float* sc = (float*)smem;
  float* red = sc + 9 * 128;
  const int tid = tidx();
  __syncthreads();
  for (int i = tid; i < 9 * 128; i += 256) {
    int ci = i >> 7, k = kp * 128 + (i & 127);
    float x = (ci == 0) ? p.in[10][k] : p.in[9][(ci - 1) * 1024 + k];
    sc[i] = x / (1.f + __expf(-x));
  }
  __syncthreads();
  const int col = cb * 64 + (tid & 63), kg = tid >> 6;
  const float* wm = p.in[11] + (size_t)l * 1024 * 6144 + (size_t)(kp * 128) * 6144 + col;
  float acc[9];
#pragma unroll
  for (int c = 0; c < 9; ++c) acc[c] = 0.f;
#pragma unroll 8
  for (int k = kg; k < 128; k += 4) {
    float wv = wm[(size_t)k * 6144];
#pragma unroll
    for (int c = 0; c < 9; ++c) acc[c] += sc[c * 128 + k] * wv;
  }
#pragma unroll
  for (int c = 0; c < 9; ++c) red[(kg * 9 + c) * 64 + (tid & 63)] = acc[c];
  __syncthreads();
  float* mod = (float*)(p.ws + WS_R3 + R3_MOD);
  for (int i = tid; i < 9 * 64; i += 256) {
    int c = i >> 6, cc = i & 63;
    float sm = red[(0 * 9 + c) * 64 + cc] + red[(1 * 9 + c) * 64 + cc] + red[(2 * 9 + c) * 64 + cc] + red[(3 * 9 + c) * 64 + cc];
    int cg_ = cb * 64 + cc;
    if (kp == 0) sm += p.in[12][(size_t)l * 6144 + cg_];
    atomicAdd(&mod[((size_t)l * 9 + c) * 6144 + cg_], sm);
  }
}
DI void misc_item(const Params& p, int it) {
  float2* rope = (float2*)(p.ws + WS_R3 + R3_ROPE);
  int idx = it * 256 + tidx();
  int pos = idx >> 4, i = idx & 15;
  float inv = expf(-logf(10000.f) * (float)(i & 7) / 8.f);
  float ang = (float)((i < 8) ? (pos >> 6) : (pos & 63)) * inv;
  float s, c;
  sincosf(ang, &s, &c);
  rope[idx] = make_float2(c, s);
  if (it == 0 && tidx() < 2) {
    int l = tidx();
    const float* lf = p.in[24] + l * 128;
    float a = 0.f, b = 0.f;
    for (int k = 0; k < 32; ++k) { a += lf[k] * lf[32 + k]; b += lf[64 + k] * lf[96 + k]; }
    float lam_init = 0.8f - 0.6f * expf(-0.3f * (float)l);
    float* lam = (float*)(p.ws + WS_R3 + R3_LAM);
    lam[l * 2] = expf(a) - expf(b) + lam_init;
    lam[l * 2 + 1] = lam_init;
  }
}

DI void rowwise_item(const Params& p, int l, int mode, int it) {
  constexpr int NR = 2;
  const int lane = tidx() & 63, w = tidx() >> 6;
  const float* mod = (const float*)(p.ws + WS_R3 + R3_MOD);
  int row[NR], ci[NR];
  float4 xv[NR][4];
#pragma unroll
  for (int q = 0; q < NR; ++q) { row[q] = it * 8 + q * 4 + w; ci[q] = midx_of(row[q]); }
  if (mode == 0) {
#pragma unroll
    for (int q = 0; q < NR; ++q) {
      const float* src = (row[q] < TC) ? p.in[0] + (size_t)row[q] * 1024 : p.in[1] + (size_t)(row[q] - TC) * 1024;
#pragma unroll
      for (int i = 0; i < 4; ++i) xv[q][i] = *(const float4*)(src + i * 256 + lane * 4);
    }
  } else {
    const float* ng = p.in[13] + ((size_t)l * 4 + (mode == 1 ? 1 : 3)) * 1024;
    float4 yv[NR][4];
    float ss[NR];
#pragma unroll
    for (int q = 0; q < NR; ++q) {
      const u16* Y = (mode == 1) ? (const u16*)(p.ws + WS_R1) + (size_t)row[q] * 1024 : (const u16*)(p.ws + WS_R2) + (size_t)row[q] * 1024;
      const float* X = p.out + (size_t)row[q] * 1024;
      ss[q] = 0.f;
#pragma unroll
      for (int i = 0; i < 4; ++i) {
        const uint2 yb = *(const uint2*)(Y + i * 256 + lane * 4);
        xv[q][i] = *(const float4*)(X + i * 256 + lane * 4);
        yv[q][i] = make_float4(bf2f(yb.x & 0xffff), bf2f(yb.x >> 16), bf2f(yb.y & 0xffff), bf2f(yb.y >> 16));
        ss[q] += yv[q][i].x * yv[q][i].x + yv[q][i].y * yv[q][i].y + yv[q][i].z * yv[q][i].z + yv[q][i].w * yv[q][i].w;
      }
    }
#pragma unroll
    for (int q = 0; q < NR; ++q) ss[q] = wave_sum(ss[q]);
#pragma unroll
    for (int q = 0; q < NR; ++q) {
      const float rs = rsqrtf(ss[q] * (1.f / 1024.f) + EPS);
      const float* gm = mod + ((size_t)l * 9 + ci[q]) * 6144 + (mode == 1 ? 2048 : 5120);
#pragma unroll
      for (int i = 0; i < 4; ++i) {
        const int c = i * 256 + lane * 4;
        float4 x0 = xv[q][i];
        float4 g = *(const float4*)(ng + c);
        float4 gg = *(const float4*)(gm + c);
        x0.x += gg.x * (yv[q][i].x * rs * g.x); x0.y += gg.y * (yv[q][i].y * rs * g.y);
        x0.z += gg.z * (yv[q][i].z * rs * g.z); x0.w += gg.w * (yv[q][i].w * rs * g.w);
        xv[q][i] = x0;
      }
    }
  }
#pragma unroll
  for (int q = 0; q < NR; ++q) {
    float* X = p.out + (size_t)row[q] * 1024;
#pragma unroll
    for (int i = 0; i < 4; ++i) *(float4*)(X + i * 256 + lane * 4) = xv[q][i];
  }
  int ln = l, ngi = 2, off_sh = 3072, off_sc = 4096;
  if (mode == 0) { ln = 0; ngi = 0; off_sh = 0; off_sc = 1024; }
  if (mode == 2) { ln = l + 1; ngi = 0; off_sh = 0; off_sc = 1024; }
  if (ln >= 2) return;
  float s2[NR];
#pragma unroll
  for (int q = 0; q < NR; ++q) {
    s2[q] = 0.f;
#pragma unroll
    for (int i = 0; i < 4; ++i) s2[q] += xv[q][i].x * xv[q][i].x + xv[q][i].y * xv[q][i].y + xv[q][i].z * xv[q][i].z + xv[q][i].w * xv[q][i].w;
  }
#pragma unroll
  for (int q = 0; q < NR; ++q) s2[q] = wave_sum(s2[q]);
  const float* ng = p.in[13] + ((size_t)ln * 4 + ngi) * 1024;
#pragma unroll
  for (int q = 0; q < NR; ++q) {
    const float rs = rsqrtf(s2[q] * (1.f / 1024.f) + EPS);
    const float* mm = mod + ((size_t)ln * 9 + ci[q]) * 6144;
    u16* H = (u16*)(p.ws + WS_H) + (size_t)row[q] * LDH;
#pragma unroll
    for (int i = 0; i < 4; ++i) {
      const int c = i * 256 + lane * 4;
      float4 g = *(const float4*)(ng + c);
      float4 sc = *(const float4*)(mm + off_sc + c);
      float4 sh = *(const float4*)(mm + off_sh + c);
      uint2 o;
      o.x = pk2(xv[q][i].x * rs * g.x * (1.f + sc.x) + sh.x, xv[q][i].y * rs * g.y * (1.f + sc.y) + sh.y);
      o.y = pk2(xv[q][i].z * rs * g.z * (1.f + sc.z) + sh.z, xv[q][i].w * rs * g.w * (1.f + sc.w) + sh.w);
      *(uint2*)(H + c) = o;
    }
  }
}

DI void p1_item(const Params& p, int l, int mt, int nt, char* smem, bool hn, int nmt, int nnt, bool* primed) {
  const int m0 = mt * 192, n0 = nt * 128;
  const u16* H = (const u16*)(p.ws + WS_H);
  const u16* W = (const u16*)(p.ws + WS_WB) + WB_IN;
  f32x16 acc[3][2];
  zero_acc(acc);
  gemm_kloop<3, 128>(H + (size_t)m0 * LDH, LDH, W + (size_t)n0 * LDH, LDH, 1024, smem, acc,
                     hn ? GNext{H + (size_t)nmt * 192 * LDH, W + (size_t)nnt * 128 * LDH} : GNext{nullptr, nullptr}, primed);
  u16* Z = (u16*)(p.ws + WS_R1 + R1_Z);
  float* gates = (float*)(p.ws + WS_R3 + R3_GATES);
  float* out = p.out;
  const int lane = tidx() & 63, r = lane & 31, h = lane >> 5;
  epi_each<3, 128>(acc, m0, n0, [&](f32x16& a, int rbase, int cbase) {
    quad_tr(a, lane);
    const int c0 = cbase + (r & ~3);
    if (c0 >= ZLD) return;
#pragma unroll
    for (int g = 0; g < 4; ++g) {
      const int row = rbase + 8 * g + 4 * h + (lane & 3);
      const float4 v = make_float4(a[4 * g], a[4 * g + 1], a[4 * g + 2], a[4 * g + 3]);
      uint2 zb; zb.x = pk2(v.x, v.y); zb.y = pk2(v.z, v.w);
      *(uint2*)(Z + (size_t)row * ZLD + c0) = zb;
      if (c0 >= 1952 && c0 < 1968) *(float4*)(gates + (size_t)row * 16 + (c0 - 1952)) = v;
      if (row < TC) {
        const int b = row >> 8, pos = row & 255;
        const size_t rb = ((size_t)(b * 2 + l) * 256 + pos);
        if (c0 >= 384 && c0 < 416) *(float4*)(out + O_KR + rb * 32 + (c0 - 384)) = v;
        else if (c0 >= 2224 && c0 < 2480) *(float4*)(out + O_DK + rb * 256 + (c0 - 2224)) = v;
        else if (c0 >= 2480) *(float4*)(out + O_DV + rb * 256 + (c0 - 2480)) = v;
      }
    }
  });
}

DI void prep_token(const Params& p, int l, int row) {
  const int lane = tidx() & 63;
  const u16* z = (const u16*)(p.ws + WS_R1 + R1_Z) + (size_t)row * ZLD;
  const bool lat = row >= TC;
  const int pos = lat ? ((row - TC) & 1023) : 0;
  const int kr_ = keyrow_of(row);
  const float2* rope = (const float2*)(p.ws + WS_R3 + R3_ROPE) + pos * 16;
  {
    uint2 v = *(const uint2*)(z + lane * 4);
    float x0 = bf2f(v.x & 0xffff), x1 = bf2f(v.x >> 16), x2 = bf2f(v.y & 0xffff), x3 = bf2f(v.y >> 16);
    float ss = wave_sum(x0 * x0 + x1 * x1 + x2 * x2 + x3 * x3);
    float rs = rsqrtf(ss * (1.f / 256.f) + EPS);
    float4 g = *(const float4*)(p.in[15] + l * 256 + lane * 4);
    uint2 o;
    o.x = pk2(x0 * rs * g.x, x1 * rs * g.y);
    o.y = pk2(x2 * rs * g.z, x3 * rs * g.w);
    *(uint2*)((u16*)(p.ws + WS_R2 + R2_CQ) + (size_t)row * 256 + lane * 4) = o;
  }
  {
    unsigned v = *(const unsigned*)(z + 256 + lane * 2);
    float x0 = bf2f(v & 0xffff), x1 = bf2f(v >> 16);
    float ss = wave_sum(x0 * x0 + x1 * x1);
    float rs = rsqrtf(ss * (1.f / 128.f) + EPS);
    float2 g = *(const float2*)(p.in[17] + l * 128 + lane * 2);
    float y0 = x0 * rs * g.x, y1 = x1 * rs * g.y;
    *(unsigned*)((u16*)(p.ws + WS_R2 + R2_CKV) + (size_t)kr_ * 128 + lane * 2) = pk2(y0, y1);
    if (!lat) {
      const int b = row >> 8, ps = row & 255;
      *(float2*)(p.out + O_CKV + ((size_t)(b * 2 + l) * 256 + ps) * 128 + lane * 2) = make_float2(y0, y1);
    }
  }
  if (lane < 16) {
    float x1 = bf2f(z[384 + lane]), x2 = bf2f(z[400 + lane]);
    if (lat) {
      float2 cs = rope[lane];
      float a = x1 * cs.x - x2 * cs.y, b = x1 * cs.y + x2 * cs.x;
      x1 = a; x2 = b;
    }
    u16* km = (u16*)(p.ws + WS_R2 + R2_KMLA) + (size_t)kr_ * 384;
    const u16 b1 = f2bf(x1), b2 = f2bf(x2);
#pragma unroll
    for (int hh = 0; hh < 4; ++hh) { km[hh * 96 + 64 + lane] = b1; km[hh * 96 + 80 + lane] = b2; }
  }
  {
    uint2 v = *(const uint2*)(z + 672 + lane * 4);
    float x0 = bf2f(v.x & 0xffff), x1 = bf2f(v.x >> 16), x2 = bf2f(v.y & 0xffff), x3 = bf2f(v.y >> 16);
    float ss = wave_sum(x0 * x0 + x1 * x1 + x2 * x2 + x3 * x3);
    if (lane == 0) ((float*)(p.ws + WS_R3 + R3_RSTDV))[row] = rsqrtf(ss * (1.f / 256.f) + EPS);
  }
  {
    u16* qd = (u16*)(p.ws + WS_R3 + R3_QD) + (size_t)row * 256;
    u16* kd = (u16*)(p.ws + WS_R3 + R3_KD) + (size_t)kr_ * 256;
    const float qs = 0.17677669529663687f * LOG2E;
#pragma unroll
    for (int t = 0; t < 2; ++t) {
      const int pr = lane * 2 + t, hh = pr >> 4, i = pr & 15;
      float q1 = bf2f(z[ZD + hh * 32 + i]), q2 = bf2f(z[ZD + hh * 32 + 16 + i]);
      float k1 = bf2f(z[ZD + 256 + hh * 32 + i]), k2 = bf2f(z[ZD + 256 + hh * 32 + 16 + i]);
      if (lat) {
        float2 cs = rope[i];
        float a = q1 * cs.x - q2 * cs.y, b = q1 * cs.y + q2 * cs.x; q1 = a; q2 = b;
        a = k1 * cs.x - k2 * cs.y; b = k1 * cs.y + k2 * cs.x; k1 = a; k2 = b;
      }
      qd[hh * 32 + i] = f2bf(q1 * qs); qd[hh * 32 + 16 + i] = f2bf(q2 * qs);
      kd[hh * 32 + i] = f2bf(k1); kd[hh * 32 + 16 + i] = f2bf(k2);
    }
    *(uint2*)((u16*)(p.ws + WS_R3 + R3_VD) + (size_t)kr_ * 256 + lane * 4) = *(const uint2*)(z + ZD + 512 + lane * 4);
  }
}
DI void prep_cached(const Params& p, int l, int idx) {
  const int lane = tidx() & 63;
  const int b = idx >> 8, ps = idx & 255;
  const int kr_ = TC + b * 1280 + ps;
  const size_t rb = (size_t)(b * 2 + l) * 256 + ps;
  {
    float2 v = *(const float2*)(p.in[2] + rb * 128 + lane * 2);
    *(unsigned*)((u16*)(p.ws + WS_R2 + R2_CKV) + (size_t)kr_ * 128 + lane * 2) = pk2(v.x, v.y);
  }
  if (lane < 32) {
    u16 v = f2bf(p.in[3][rb * 32 + lane]);
    u16* km = (u16*)(p.ws + WS_R2 + R2_KMLA) + (size_t)kr_ * 384;
#pragma unroll
    for (int hh = 0; hh < 4; ++hh) km[hh * 96 + 64 + lane] = v;
  }
  {
    float4 k = *(const float4*)(p.in[4] + rb * 256 + lane * 4);
    float4 v = *(const float4*)(p.in[5] + rb * 256 + lane * 4);
    uint2 o;
    o.x = pk2(k.x, k.y); o.y = pk2(k.z, k.w);
    *(uint2*)((u16*)(p.ws + WS_R3 + R3_KD) + (size_t)kr_ * 256 + lane * 4) = o;
    o.x = pk2(v.x, v.y); o.y = pk2(v.z, v.w);
    *(uint2*)((u16*)(p.ws + WS_R3 + R3_VD) + (size_t)kr_ * 256 + lane * 4) = o;
  }
}

struct MItem { int lat, b, hh, tc, nc, row0, chunk0; };
DI MItem mitem(int it) {
  MItem m;
  if (it < 256) { m.lat = 0; m.b = it >> 4; m.hh = (it >> 2) & 3; m.tc = it & 3; m.nc = 4; m.row0 = m.b * 256 + m.tc * 64; m.chunk0 = m.b * 4; }
  else { it -= 256; m.lat = 1; m.b = it >> 6; m.hh = (it >> 4) & 3; m.tc = it & 15; m.nc = 16; m.row0 = TC + m.b * 1024 + m.tc * 64; m.chunk0 = 64 + m.b * 16; }
  return m;
}
DI float logsigmoidf_(float x) { return fminf(x, 0.f) - log1pf(__expf(-fabsf(x))); }

DI void m1_item(const Params& p, int l, int it, char* smem) {
  const MItem m = mitem(it);
  const int tid = tidx(), lane = tid & 63, w = tid >> 6, r = lane & 31, h = lane >> 5;
  float* wS = (float*)smem;
  u16* KT = (u16*)(smem + 512);
  u16* VwT = KT + 64 * 72;
  const float* gates = (const float*)(p.ws + WS_R3 + R3_GATES);
  float* GB = (float*)(p.ws + WS_R3 + R3_GB);
  float* GI = (float*)(p.ws + WS_R3 + R3_GI);
  float* CHB = (float*)(p.ws + WS_R3 + R3_CHB);
  float* CHM = (float*)(p.ws + WS_R3 + R3_CHM);
  __syncthreads();
  if (w < 2) {
    const int dir = w, j = lane, tau = dir ? 63 - j : j, row = m.row0 + tau;
    const float* gb = p.in[22] + l * 16 + dir * 8;
    float ip = gates[(size_t)row * 16 + dir * 8 + m.hh] + gb[m.hh];
    float fp = gates[(size_t)row * 16 + dir * 8 + 4 + m.hh] + gb[4 + m.hh];
    float b = logsigmoidf_(fp);
#pragma unroll
    for (int d = 1; d < 64; d <<= 1) { float t = __shfl_up(b, d); if (lane >= d) b += t; }
    float bT = __shfl(b, 63);
    float a = bT - b + ip;
    float ml = wave_max(a);
    wS[dir * 64 + tau] = __expf(a - ml);
    GB[(size_t)(dir * 4 + m.hh) * T + row] = b;
    GI[(size_t)(dir * 4 + m.hh) * T + row] = ip;
    if (lane == 0) {
      const int cdir = dir ? m.nc - 1 - m.tc : m.tc;
      CHB[(dir * 4 + m.hh) * NCHUNK + m.chunk0 + cdir] = bT;
      CHM[(dir * 4 + m.hh) * NCHUNK + m.chunk0 + cdir] = ml;
    }
  }
  __syncthreads();
  const u16* Z = (const u16*)(p.ws + WS_R1 + R1_Z);
  {
    const int tau = tid & 63;
    const u16* zr = Z + (size_t)(m.row0 + tau) * ZLD + ZC + m.hh * 64;
    const float w0 = wS[tau], w1 = wS[64 + tau];
#pragma unroll
    for (int i = 0; i < 2; ++i) {
      const int dc = (tid >> 6) + 4 * i;
      uint4 kv = *(const uint4*)(zr + 256 + dc * 8);
      uint4 vv = *(const uint4*)(zr + 512 + dc * 8);
      const unsigned kk[4] = {kv.x, kv.y, kv.z, kv.w};
      const unsigned vq[4] = {vv.x, vv.y, vv.z, vv.w};
#pragma unroll
      for (int q = 0; q < 4; ++q) {
        float k0 = bf2f(kk[q] & 0xffff) * 0.125f, k1 = bf2f(kk[q] >> 16) * 0.125f;
        float v0 = bf2f(vq[q] & 0xffff), v1 = bf2f(vq[q] >> 16);
        const int d = dc * 8 + q * 2;
        KT[d * 72 + tau] = f2bf(k0); KT[(d + 1) * 72 + tau] = f2bf(k1);
        VwT[d * 72 + tau] = f2bf(v0 * w0); VwT[(d + 1) * 72 + tau] = f2bf(v1 * w0);
        VwT[64 * 72 + d * 72 + tau] = f2bf(v0 * w1); VwT[64 * 72 + (d + 1) * 72 + tau] = f2bf(v1 * w1);
      }
    }
  }
  __syncthreads();
  {
    const int dir = w >> 1, et = w & 1;
    const int cdir = dir ? m.nc - 1 - m.tc : m.tc;
    f32x16 acc[2];
    zero16(acc[0]); zero16(acc[1]);
#pragma unroll
    for (int ks = 0; ks < 4; ++ks) {
      bf16x8 a = *(const bf16x8*)(VwT + dir * 64 * 72 + (et * 32 + r) * 72 + ks * 16 + h * 8);
#pragma unroll
      for (int dt = 0; dt < 2; ++dt) {
        bf16x8 b = *(const bf16x8*)(KT + (dt * 32 + r) * 72 + ks * 16 + h * 8);
        acc[dt] = MFMA32(a, b, acc[dt]);
      }
    }
    float* DC = (float*)(p.ws + WS_R3 + R3_DC) + ((size_t)(dir * 4 + m.hh) * NCHUNK + m.chunk0 + cdir) * 4096;
#pragma unroll
    for (int dt = 0; dt < 2; ++dt)
#pragma unroll
      for (int reg = 0; reg < 16; ++reg) DC[(et * 32 + crow(reg, h)) * 64 + dt * 32 + r] = acc[dt][reg];
  }
  if (tid < 128) {
    const int dir = tid >> 6, d = tid & 63;
    const int cdir = dir ? m.nc - 1 - m.tc : m.tc;
    float s = 0.f;
    for (int tau = 0; tau < 64; ++tau) s += wS[dir * 64 + tau] * bf2f(KT[d * 72 + tau]);
    ((float*)(p.ws + WS_R3 + R3_DN))[((size_t)(dir * 4 + m.hh) * NCHUNK + m.chunk0 + cdir) * 64 + d] = s;
  }
}

DI void p3_item(const Params& p, int l, int it, char* smem) {
  const int lane = tidx() & 63, r = lane & 31, h = lane >> 5;
  f32x16 acc[2][2];
  zero_acc(acc);
  if (it < 288) {
    const int mt = it / 3, nt = it % 3, m0 = mt * 128, n0 = nt * 128;
    gemm_kloop<2, 128>((const u16*)(p.ws + WS_R2 + R2_CQ) + (size_t)m0 * 256, 256, (const u16*)(p.ws + WS_WB) + WB_UQ + (size_t)n0 * 256, 256, 256, smem, acc);
    u16* Q = (u16*)(p.ws + WS_R2 + R2_QMLA);
    const float2* rope = (const float2*)(p.ws + WS_R3 + R3_ROPE);
    const float qs = 0.10206207261596577f * LOG2E;
    epi_each<2, 128>(acc, m0, n0, [&](f32x16& a, int rbase, int cbase) {
      const bool is_rope = (cbase % 96) == 64;
      const bool lat = rbase >= TC;
#pragma unroll
      for (int reg = 0; reg < 16; ++reg) {
        const int row = rbase + crow(reg, h);
        float v = a[reg];
        if (is_rope) {
          float o = __shfl_xor(v, 16);
          if (lat) {
            float2 cs = rope[((row - TC) & 1023) * 16 + (r & 15)];
            v = (r < 16) ? (v * cs.x - o * cs.y) : (o * cs.y + v * cs.x);
          }
        }
        Q[(size_t)row * 384 + cbase + r] = f2bf(v * qs);
      }
    });
  } else {
    it -= 288;
    const int mt = it >> 2, nt = it & 3, m0 = mt * 128, n0 = nt * 128;
    gemm_kloop<2, 128>((const u16*)(p.ws + WS_R2 + R2_CKV) + (size_t)m0 * 128, 128, (const u16*)(p.ws + WS_WB) + WB_UKV + (size_t)n0 * 128, 128, 128, smem, acc);
    u16* Km = (u16*)(p.ws + WS_R2 + R2_KMLA);
    u16* Vm = (u16*)(p.ws + WS_R2 + R2_VMLA);
    epi_each<2, 128>(acc, m0, n0, [&](f32x16& a, int rbase, int cbase) {
      const int col = cbase + r, hh = col >> 7, cc = col & 127;
#pragma unroll
      for (int reg = 0; reg < 16; ++reg) {
        const int row = rbase + crow(reg, h);
        if (cc < 64) Km[(size_t)row * 384 + hh * 96 + cc] = f2bf(a[reg]);
        else Vm[(size_t)row * 256 + hh * 64 + (cc - 64)] = f2bf(a[reg]);
      }
    });
  }
}

template <int KW, int NS, class EPI>
DI void attn_item(const u16* __restrict__ Qb, int qld, const u16* __restrict__ Kb, int kld, const u16* __restrict__ Vb, int vld,
                  int nkeys, char* smem, EPI epi) {
  constexpr int DQ = KW / NS, NKS = DQ / 16, KLD = KW + 8, KCH = KW / 8, NKC = (64 * KCH) / 256;
  u16* Ks = (u16*)smem;
  constexpr int VLD = 68;
  u16* Vt = Ks + 64 * KLD;
  const int tid = tidx(), lane = tid & 63, w = tid >> 6, r = lane & 31, h = lane >> 5;
  bf16x8 qf[NS][NKS];
#pragma unroll
  for (int s = 0; s < NS; ++s)
#pragma unroll
    for (int ks = 0; ks < NKS; ++ks) qf[s][ks] = *(const bf16x8*)(Qb + (size_t)(w * 32 + r) * qld + s * DQ + ks * 16 + h * 8);
  f32x16 oacc[NS][2];
  float mrun[NS], lsum[NS];
#pragma unroll
  for (int s = 0; s < NS; ++s) { zero16(oacc[s][0]); zero16(oacc[s][1]); mrun[s] = -1e30f; lsum[s] = 0.f; }
  u32x4 rk[NKC], rv[2];
  auto gload = [&](int key0) {
#pragma unroll
    for (int i = 0; i < NKC; ++i) {
      const int c = tid + i * 256, key = c / KCH, kc = c % KCH;
      rk[i] = *(const u32x4*)(Kb + (size_t)(key0 + key) * kld + kc * 8);
    }
#pragma unroll
    for (int i = 0; i < 2; ++i) {
      const int key = tid & 63, ec = (tid >> 6) + 4 * i;
      rv[i] = *(const u32x4*)(Vb + (size_t)(key0 + key) * vld + ec * 8);
    }
  };
  gload(0);
  for (int key0 = 0; key0 < nkeys; key0 += 64) {
    __syncthreads();
#pragma unroll
    for (int i = 0; i < NKC; ++i) {
      const int c = tid + i * 256, key = c / KCH, kc = c % KCH;
      *(u32x4*)(Ks + key * KLD + kc * 8) = rk[i];
    }
#pragma unroll
    for (int i = 0; i < 2; ++i) {
      const int key = tid & 63, ec = (tid >> 6) + 4 * i;
      const u32x4 vv = rv[i];
#pragma unroll
      for (int q = 0; q < 4; ++q) {
        Vt[(ec * 8 + q * 2) * VLD + key] = (u16)(vv[q] & 0xffff);
        Vt[(ec * 8 + q * 2 + 1) * VLD + key] = (u16)(vv[q] >> 16);
      }
    }
    __syncthreads();
    if (key0 + 64 < nkeys) gload(key0 + 64);
#pragma unroll
    for (int s = 0; s < NS; ++s) {
      f32x16 sa[2];
      zero16(sa[0]); zero16(sa[1]);
#pragma unroll
      for (int sub = 0; sub < 2; ++sub)
#pragma unroll
        for (int ks = 0; ks < NKS; ++ks) {
          bf16x8 a = *(const bf16x8*)(Ks + (sub * 32 + r) * KLD + s * DQ + ks * 16 + h * 8);
          sa[sub] = MFMA32(a, qf[s][ks], sa[sub]);
        }
      float mx = -1e30f;
#pragma unroll
      for (int i = 0; i < 16; ++i) mx = fmaxf(mx, fmaxf(sa[0][i], sa[1][i]));
      mx = fmaxf(mx, __shfl_xor(mx, 32));
      const float mn = fmaxf(mrun[s], mx);
      const float alpha = __builtin_amdgcn_exp2f(mrun[s] - mn);
      mrun[s] = mn;
      float ps = 0.f;
#pragma unroll
      for (int sub = 0; sub < 2; ++sub)
#pragma unroll
        for (int i = 0; i < 16; ++i) { float e = __builtin_amdgcn_exp2f(sa[sub][i] - mn); sa[sub][i] = e; ps += e; }
      lsum[s] = lsum[s] * alpha + ps;
#pragma unroll
      for (int et = 0; et < 2; ++et)
#pragma unroll
        for (int i = 0; i < 16; ++i) oacc[s][et][i] *= alpha;
#pragma unroll
      for (int sub = 0; sub < 2; ++sub)
#pragma unroll
        for (int st = 0; st < 2; ++st) {
          const bf16x8 pf = pack8(sa[sub], st);
#pragma unroll
          for (int et = 0; et < 2; ++et) {
            const u16* vp = Vt + (et * 32 + r) * VLD + sub * 32 + 16 * st + 4 * h;
            s16x4 lo = *(const s16x4*)vp, hi = *(const s16x4*)(vp + 8);
            bf16x8 a = __builtin_shufflevector(lo, hi, 0, 1, 2, 3, 4, 5, 6, 7);
            oacc[s][et] = MFMA32(a, pf, oacc[s][et]);
          }
        }
    }
  }
#pragma unroll
  for (int s = 0; s < NS; ++s) {
    float lt = lsum[s] + __shfl_xor(lsum[s], 32);
    float inv = 1.f / lt;
#pragma unroll
    for (int et = 0; et < 2; ++et)
#pragma unroll
      for (int i = 0; i < 16; ++i) oacc[s][et][i] *= inv;
  }
  epi(oacc, w * 32 + r, h);
}

struct AItem { int hh, qrow0, krow0, nkeys; };
DI AItem aitem(int it) {
  AItem a;
  if (it < 256) { int b = it >> 5; a.hh = (it >> 3) & 3; int qt = it & 7; a.qrow0 = TC + b * 1024 + qt * 128; a.krow0 = TC + b * 1280; a.nkeys = 1280; }
  else { it -= 256; int b = it >> 3; a.hh = (it >> 1) & 3; int qt = it & 1; a.qrow0 = b * 256 + qt * 128; a.krow0 = b * 256; a.nkeys = 256; }
  return a;
}
DI void mla_item(const Params& p, int it, char* smem) {
  const AItem a = aitem(it);
  const u16* Q = (const u16*)(p.ws + WS_R2 + R2_QMLA) + (size_t)a.qrow0 * 384 + a.hh * 96;
  const u16* K = (const u16*)(p.ws + WS_R2 + R2_KMLA) + (size_t)a.krow0 * 384 + a.hh * 96;
  const u16* V = (const u16*)(p.ws + WS_R2 + R2_VMLA) + (size_t)a.krow0 * 256 + a.hh * 64;
  u16* Y = (u16*)(p.ws + WS_R1 + R1_YMIX);
  attn_item<96, 1>(Q, 384, K, 384, V, 256, a.nkeys, smem, [&](f32x16 (&o)[1][2], int qi, int h) {
    u16* yr = Y + (size_t)(a.qrow0 + qi) * LDH + a.hh * 64;
#pragma unroll
    for (int et = 0; et < 2; ++et)
#pragma unroll
      for (int g = 0; g < 4; ++g) {
        uint2 v;
        v.x = pk2(o[0][et][4 * g], o[0][et][4 * g + 1]);
        v.y = pk2(o[0][et][4 * g + 2], o[0][et][4 * g + 3]);
        *(uint2*)(yr + et * 32 + 8 * g + 4 * h) = v;
      }
  });
}
DI void diff_item(const Params& p, int l, int it, char* smem) {
  const AItem a = aitem(it);
  const u16* Q = (const u16*)(p.ws + WS_R3 + R3_QD) + (size_t)a.qrow0 * 256 + a.hh * 64;
  const u16* K = (const u16*)(p.ws + WS_R3 + R3_KD) + (size_t)a.krow0 * 256 + a.hh * 64;
  const u16* V = (const u16*)(p.ws + WS_R3 + R3_VD) + (size_t)a.krow0 * 256 + a.hh * 64;
  u16* Y = (u16*)(p.ws + WS_R1 + R1_YMIX);
  const float* lam = (const float*)(p.ws + WS_R3 + R3_LAM);
  const float lam_val = lam[l * 2], lam_init = lam[l * 2 + 1];
  const float* sn = p.in[25] + l * 64;
  attn_item<64, 2>(Q, 256, K, 256, V, 256, a.nkeys, smem, [&](f32x16 (&o)[2][2], int qi, int h) {
    float ss = 0.f;
#pragma unroll
    for (int et = 0; et < 2; ++et)
#pragma unroll
      for (int i = 0; i < 16; ++i) { float v = o[0][et][i] - lam_val * o[1][et][i]; o[0][et][i] = v; ss += v * v; }
    ss += __shfl_xor(ss, 32);
    const float rs = rsqrtf(ss * (1.f / 64.f) + EPS) * (1.f - lam_init);
    u16* yr = Y + (size_t)(a.qrow0 + qi) * LDH + 768 + a.hh * 64;
#pragma unroll
    for (int et = 0; et < 2; ++et)
#pragma unroll
      for (int g = 0; g < 4; ++g) {
        const int e = et * 32 + 8 * g + 4 * h;
        float4 gn = *(const float4*)(sn + e);
        uint2 v;
        v.x = pk2(o[0][et][4 * g] * rs * gn.x, o[0][et][4 * g + 1] * rs * gn.y);
        v.y = pk2(o[0][et][4 * g + 2] * rs * gn.z, o[0][et][4 * g + 3] * rs * gn.w);
        *(uint2*)(yr + e) = v;
      }
  });
}

DI void gmlp_item(const Params& p, int l, int it, char* smem) {
  const int c = it >> 2, g = it & 3;
  const int tid = tidx(), lane = tid & 63, w = tid >> 6, r = lane & 31, h = lane >> 5;
  u16* vnT = (u16*)smem;
  const u16* Z = (const u16*)(p.ws + WS_R1 + R1_Z);
  const float* rstd = (const float*)(p.ws + WS_R3 + R3_RSTDV);
  const float* vn = p.in[19] + l * 256 + g * 64;
  __syncthreads();
  {
    const int q = tid & 127, row = c * 128 + q;
    const float rs = rstd[row];
#pragma unroll
    for (int i = 0; i < 4; ++i) {
      const int dc = (tid >> 7) + 2 * i;
      uint4 v = *(const uint4*)(Z + (size_t)row * ZLD + 672 + g * 64 + dc * 8);
      const unsigned vv[4] = {v.x, v.y, v.z, v.w};
#pragma unroll
      for (int qq = 0; qq < 4; ++qq) {
        const int d = dc * 8 + qq * 2;
        vnT[d * 136 + q] = f2bf(bf2f(vv[qq] & 0xffff) * rs * vn[d]);
        vnT[(d + 1) * 136 + q] = f2bf(bf2f(vv[qq] >> 16) * rs * vn[d + 1]);
      }
    }
  }
  __syncthreads();
  const u16* Ws = (const u16*)(p.ws + WS_WB) + WB_WS + (size_t)g * 16384 + (size_t)(w * 32 + r) * 128;
  f32x16 acc[2];
  zero16(acc[0]); zero16(acc[1]);
#pragma unroll
  for (int ks = 0; ks < 8; ++ks) {
    bf16x8 b = *(const bf16x8*)(Ws + ks * 16 + h * 8);
#pragma unroll
    for (int dt = 0; dt < 2; ++dt) {
      bf16x8 a = *(const bf16x8*)(vnT + (dt * 32 + r) * 136 + ks * 16 + h * 8);
      acc[dt] = MFMA32(a, b, acc[dt]);
    }
  }
  const int pq = w * 32 + r, row = c * 128 + pq;
  const float bias = p.in[21][l * 512 + g * 128 + pq];
  const u16* zu = Z + (size_t)row * ZLD + ZB + g * 64;
  u16* yr = (u16*)(p.ws + WS_R1 + R1_YMIX) + (size_t)row * LDH + 256 + g * 64;
#pragma unroll
  for (int dt = 0; dt < 2; ++dt)
#pragma unroll
    for (int gq = 0; gq < 4; ++gq) {
      const int d = dt * 32 + 8 * gq + 4 * h;
      uint2 u = *(const uint2*)(zu + d);
      uint2 o;
      o.x = pk2(bf2f(u.x & 0xffff) * (acc[dt][4 * gq] + bias), bf2f(u.x >> 16) * (acc[dt][4 * gq + 1] + bias));
      o.y = pk2(bf2f(u.y & 0xffff) * (acc[dt][4 * gq + 2] + bias), bf2f(u.y >> 16) * (acc[dt][4 * gq + 3] + bias));
      *(uint2*)(yr + d) = o;
    }
}

DI void scan_item(const Params& p, int l, int it) {
  const int slice = it & 3, sq = it >> 2;
  const int s_ = sq % 24, dh = sq / 24, dir = dh >> 2, hh = dh & 3;
  const bool lat = s_ >= 16;
  const int b = lat ? s_ - 16 : s_, nc = lat ? 16 : 4, chunk0 = lat ? 64 + b * 16 : b * 4;
  const int tid = tidx();
  const int idx = slice * 1024 + tid * 4, e_ = idx >> 6, d0 = idx & 63;
  float* DC = (float*)(p.ws + WS_R3 + R3_DC);
  float* DN = (float*)(p.ws + WS_R3 + R3_DN);
  float* MST = (float*)(p.ws + WS_R3 + R3_MST);
  const float* CHB = (const float*)(p.ws + WS_R3 + R3_CHB);
  const float* CHM = (const float*)(p.ws + WS_R3 + R3_CHM);
  const size_t sb = (size_t)dh * NCHUNK + chunk0;
  const size_t st = ((size_t)(b * 2 + l) * 2 + dir) * 4 + hh;
  float4 C = make_float4(0.f, 0.f, 0.f, 0.f);
  float nval = 0.f, mcur = 0.f;
  const bool nthr = (slice == 0) && (tid < 64);
  if (lat) {
    const float* C0 = p.in[6] + st * 4096;
    C.x = C0[(d0 + 0) * 64 + e_]; C.y = C0[(d0 + 1) * 64 + e_]; C.z = C0[(d0 + 2) * 64 + e_]; C.w = C0[(d0 + 3) * 64 + e_];
    if (nthr) nval = p.in[7][st * 64 + tid];
    mcur = p.in[8][st];
  }
  float4 cur = *(const float4*)(DC + sb * 4096 + idx);
  float dn = nthr ? DN[sb * 64 + tid] : 0.f;
  for (int k = 0; k < nc; ++k) {
    float4 nxt = cur;
    float dnn = dn;
    if (k + 1 < nc) {
      nxt = *(const float4*)(DC + (sb + k + 1) * 4096 + idx);
      if (nthr) dnn = DN[(sb + k + 1) * 64 + tid];
    }
    *(float4*)(DC + (sb + k) * 4096 + idx) = C;
    if (nthr) DN[(sb + k) * 64 + tid] = nval;
    if (slice == 0 && tid == 0) MST[sb + k] = mcur;
    const float bT = CHB[sb + k], ml = CHM[sb + k];
    const float mn = fmaxf(bT + mcur, ml);
    const float wo = __expf(bT + mcur - mn), wn = __expf(ml - mn);
    C.x = wo * C.x + wn * cur.x; C.y = wo * C.y + wn * cur.y; C.z = wo * C.z + wn * cur.z; C.w = wo * C.w + wn * cur.w;
    nval = wo * nval + wn * dn;
    mcur = mn;
    cur = nxt; dn = dnn;
  }
  if (!lat) {
    float* oc = p.out + O_C + st * 4096;
    oc[(d0 + 0) * 64 + e_] = C.x; oc[(d0 + 1) * 64 + e_] = C.y; oc[(d0 + 2) * 64 + e_] = C.z; oc[(d0 + 3) * 64 + e_] = C.w;
    if (nthr) p.out[O_N + st * 64 + tid] = nval;
    if (slice == 0 && tid == 0) p.out[O_M + st] = mcur;
  }
}

DI void m3_item(const Params& p, int l, int it, char* smem) {
  const MItem m = mitem(it);
  const int tid = tidx(), lane = tid & 63, w = tid >> 6, r = lane & 31, h = lane >> 5;
  u16* CtS = (u16*)smem;
  u16* VT = CtS + 2 * 64 * 72;
  float* hbuf = (float*)(smem + 27648);
  float* nS = (float*)(smem + 27648 + 16384);
  float* gbS = nS + 128;
  float* giS = gbS + 128;
  const float* DC = (const float*)(p.ws + WS_R3 + R3_DC);
  const float* DN = (const float*)(p.ws + WS_R3 + R3_DN);
  const float* CHB = (const float*)(p.ws + WS_R3 + R3_CHB);
  const float* CHM = (const float*)(p.ws + WS_R3 + R3_CHM);
  const float* GB = (const float*)(p.ws + WS_R3 + R3_GB);
  const float* GI = (const float*)(p.ws + WS_R3 + R3_GI);
  const u16* Z = (const u16*)(p.ws + WS_R1 + R1_Z);
  __syncthreads();
  float mc[2];
  const int e_ = tid >> 2, d0 = (tid & 3) * 16;
  const float* MST = (const float*)(p.ws + WS_R3 + R3_MST);
#pragma unroll
  for (int dir = 0; dir < 2; ++dir) {
    const int cdir = dir ? m.nc - 1 - m.tc : m.tc;
    const size_t sb = (size_t)(dir * 4 + m.hh) * NCHUNK + m.chunk0 + cdir;
    const float* dc = DC + sb * 4096 + e_ * 64 + d0;
#pragma unroll
    for (int i = 0; i < 16; i += 4) {
      const float4 v = *(const float4*)(dc + i);
      *(unsigned*)(CtS + dir * 4608 + e_ * 72 + d0 + i) = pk2(v.x, v.y);
      *(unsigned*)(CtS + dir * 4608 + e_ * 72 + d0 + i + 2) = pk2(v.z, v.w);
    }
    if (tid < 64) nS[dir * 64 + tid] = DN[sb * 64 + tid];
    mc[dir] = MST[sb];
  }
  if (tid < 128) {
    const int dir = tid >> 6, tau = tid & 63;
    gbS[dir * 64 + tau] = GB[(size_t)(dir * 4 + m.hh) * T + m.row0 + tau];
    giS[dir * 64 + tau] = GI[(size_t)(dir * 4 + m.hh) * T + m.row0 + tau];
  }
  {
    const int tau = tid & 63;
    const u16* zr = Z + (size_t)(m.row0 + tau) * ZLD + ZC + 512 + m.hh * 64;
#pragma unroll
    for (int i = 0; i < 2; ++i) {
      const int dc = (tid >> 6) + 4 * i;
      uint4 vv = *(const uint4*)(zr + dc * 8);
      const unsigned vq[4] = {vv.x, vv.y, vv.z, vv.w};
#pragma unroll
      for (int q = 0; q < 4; ++q) {
        VT[(dc * 8 + q * 2) * 72 + tau] = (u16)(vq[q] & 0xffff);
        VT[(dc * 8 + q * 2 + 1) * 72 + tau] = (u16)(vq[q] >> 16);
      }
    }
  }
  __syncthreads();
  const int tt = w & 1, dir = w >> 1;
  const int t = tt * 32 + r;
  const float mcd = dir ? mc[1] : mc[0];
  const float* gb = gbS + dir * 64;
  const float* gi = giS + dir * 64;
  bf16x8 qf[4];
  const u16* zq = Z + (size_t)(m.row0 + t) * ZLD + ZC + m.hh * 64;
  float qn = 0.f;
#pragma unroll
  for (int ks = 0; ks < 4; ++ks) {
    qf[ks] = *(const bf16x8*)(zq + ks * 16 + h * 8);
#pragma unroll
    for (int j = 0; j < 8; ++j) qn += bf2f((u16)qf[ks][j]) * nS[dir * 64 + ks * 16 + h * 8 + j];
  }
  qn += __shfl_xor(qn, 32);
  const float bt = gb[t];
  float mxi = -1e30f;
  for (int s = 0; s < 64; ++s) {
    const bool ok = dir ? (s >= t) : (s <= t);
    const float v = gi[s] - gb[s];
    mxi = ok ? fmaxf(mxi, v) : mxi;
  }
  const float mt = fmaxf(bt + mcd, bt + mxi);
  const float w_inter = __expf(bt + mcd - mt);
  f32x16 num[2];
  zero16(num[0]); zero16(num[1]);
#pragma unroll
  for (int ks = 0; ks < 4; ++ks)
#pragma unroll
    for (int et = 0; et < 2; ++et) {
      bf16x8 a = *(const bf16x8*)(CtS + dir * 4608 + (et * 32 + r) * 72 + ks * 16 + h * 8);
      num[et] = MFMA32(a, qf[ks], num[et]);
    }
#pragma unroll
  for (int et = 0; et < 2; ++et)
#pragma unroll
    for (int i = 0; i < 16; ++i) num[et][i] *= w_inter;
  float den = 0.f;
#pragma unroll
  for (int st = 0; st < 2; ++st) {
    f32x16 sa;
    zero16(sa);
    const u16* zk = Z + (size_t)(m.row0 + st * 32 + r) * ZLD + ZC + 256 + m.hh * 64;
#pragma unroll
    for (int ks = 0; ks < 4; ++ks) {
      bf16x8 a = *(const bf16x8*)(zk + ks * 16 + h * 8);
      sa = MFMA32(a, qf[ks], sa);
    }
#pragma unroll
    for (int reg = 0; reg < 16; ++reg) {
      const int s = st * 32 + crow(reg, h);
      const bool ok = dir ? (s >= t) : (s <= t);
      const float dl = bt - gb[s] + gi[s] - mt;
      const float pv = ok ? sa[reg] * 0.125f * __expf(dl) : 0.f;
      sa[reg] = pv;
      den += pv;
    }
#pragma unroll
    for (int s2 = 0; s2 < 2; ++s2) {
      const bf16x8 pf = pack8(sa, s2);
#pragma unroll
      for (int et = 0; et < 2; ++et) {
        const u16* vp = VT + (et * 32 + r) * 72 + st * 32 + 16 * s2 + 4 * h;
        s16x4 lo = *(const s16x4*)vp, hi = *(const s16x4*)(vp + 8);
        bf16x8 a = __builtin_shufflevector(lo, hi, 0, 1, 2, 3, 4, 5, 6, 7);
        num[et] = MFMA32(a, pf, num[et]);
      }
    }
  }
  den += __shfl_xor(den, 32);
  den += w_inter * qn;
  const float dinv = 1.f / fmaxf(fabsf(den), __expf(-mt));
#pragma unroll
  for (int et = 0; et < 2; ++et)
#pragma unroll
    for (int i = 0; i < 16; ++i) num[et][i] *= dinv;
  if (dir == 1) {
#pragma unroll
    for (int et = 0; et < 2; ++et)
#pragma unroll
      for (int i = 0; i < 16; ++i) hbuf[(tt * 32 + et * 16 + i) * 64 + lane] = num[et][i];
  }
  __syncthreads();
  if (dir == 0) {
    float ss = 0.f;
#pragma unroll
    for (int et = 0; et < 2; ++et)
#pragma unroll
      for (int i = 0; i < 16; ++i) { float v = num[et][i] + hbuf[(tt * 32 + et * 16 + i) * 64 + lane]; num[et][i] = v; ss += v * v; }
    ss += __shfl_xor(ss, 32);
    const float rs = rsqrtf(ss * (1.f / 64.f) + EPS);
    const int row = m.row0 + t;
    const u16* zo = Z + (size_t)row * ZLD + ZC + 768 + m.hh * 64;
    const float* hn = p.in[23] + l * 256 + m.hh * 64;
    u16* yr = (u16*)(p.ws + WS_R1 + R1_YMIX) + (size_t)row * LDH + 512 + m.hh * 64;
#pragma unroll
    for (int et = 0; et < 2; ++et)
#pragma unroll
      for (int g = 0; g < 4; ++g) {
        const int e = et * 32 + 8 * g + 4 * h;
        uint2 ov = *(const uint2*)(zo + e);
        float4 gn = *(const float4*)(hn + e);
        uint2 o;
        o.x = pk2(sigmoidf_(bf2f(ov.x & 0xffff)) * num[et][4 * g] * rs * gn.x, sigmoidf_(bf2f(ov.x >> 16)) * num[et][4 * g + 1] * rs * gn.y);
        o.y = pk2(sigmoidf_(bf2f(ov.y & 0xffff)) * num[et][4 * g + 2] * rs * gn.z, sigmoidf_(bf2f(ov.y >> 16)) * num[et][4 * g + 3] * rs * gn.w);
        *(uint2*)(yr + e) = o;
      }
  }
}

DI u16* gate_ptr(const Params& p, int n) {
  if (n < 2) return (u16*)(p.ws + WS_R1) + (size_t)n * T * 1024;
  if (n == 2) return (u16*)(p.ws + WS_R3);
  return (u16*)(p.ws + WS_R2 + R2_G3);
}
DI void p5a_item(const Params& p, int l, int mt, int nt, char* smem, bool hn, int nmt, int nnt, bool* primed) {
  const int m0 = mt * 192, n0 = nt * 128;
  f32x16 acc[3][2];
  zero_acc(acc);
  gemm_kloop<3, 128>((const u16*)(p.ws + WS_H) + (size_t)m0 * LDH, LDH, (const u16*)(p.ws + WS_WB) + WB_MG + (size_t)n0 * LDH, LDH, 1024, smem, acc,
                     hn ? GNext{(const u16*)(p.ws + WS_H) + (size_t)nmt * 192 * LDH, (const u16*)(p.ws + WS_WB) + WB_MG + (size_t)nnt * 128 * LDH} : GNext{nullptr, nullptr}, primed);
  u16* G = gate_ptr(p, n0 >> 10);
  const float* bm = p.in[28] + (size_t)l * 4096;
  const int lane = tidx() & 63, r = lane & 31, h = lane >> 5;
  epi_each<3, 128>(acc, m0, n0, [&](f32x16& a, int rbase, int cbase) {
    const float bias = bm[cbase + r];
    const int d = (cbase & 1023) + r;
#pragma unroll
    for (int reg = 0; reg < 16; ++reg) G[(size_t)(rbase + crow(reg, h)) * 1024 + d] = f2bf(sigmoidf_(a[reg] + bias));
  });
}
DI void p5b_item(const Params& p, int mt, int nt, char* smem, bool hn, int nmt, int nnt, bool* primed) {
  const int m0 = mt * 128, n0 = nt * 64;
  const u16* Ym = (const u16*)(p.ws + WS_R1 + R1_YMIX) + (size_t)m0 * LDH;
  const u16* wb = (const u16*)(p.ws + WS_WB);
  const int lane = tidx() & 63, r = lane & 31, h = lane >> 5;
  const int w = tidx() >> 6, wm = w >> 1, wn = w & 1;
  f32x16 tot[2][1];
  zero_acc(tot);
#pragma unroll 1
  for (int n = 0; n < 4; ++n) {
    const u16* G = gate_ptr(p, n);
    uint2 gv[2][4];
#pragma unroll
    for (int i = 0; i < 2; ++i)
#pragma unroll
      for (int g = 0; g < 4; ++g)
        gv[i][g] = *(const uint2*)(G + (size_t)(m0 + wm * 64 + i * 32 + 8 * g + 4 * h + (lane & 3)) * 1024 + n0 + wn * 32 + (r & ~3));
    f32x16 ab[2][1];
    zero_acc(ab);
    GNext nx{nullptr, nullptr};
    if (n < 3) nx = GNext{Ym + (n + 1) * 256, wb + WB_BR + (size_t)((n + 1) * 1024 + n0) * 256};
    else if (hn) nx = GNext{(const u16*)(p.ws + WS_R1 + R1_YMIX) + (size_t)nmt * 128 * LDH, wb + WB_BR + (size_t)(nnt * 64) * 256};
    gemm_kloop<2, 64>(Ym + n * 256, LDH, wb + WB_BR + (size_t)(n * 1024 + n0) * 256, 256, 256, smem, ab, nx, primed);
#pragma unroll
    for (int i = 0; i < 2; ++i) {
      quad_tr(ab[i][0], lane);
#pragma unroll
      for (int g = 0; g < 4; ++g) {
        tot[i][0][4 * g] += bf2f(gv[i][g].x & 0xffff) * ab[i][0][4 * g];
        tot[i][0][4 * g + 1] += bf2f(gv[i][g].x >> 16) * ab[i][0][4 * g + 1];
        tot[i][0][4 * g + 2] += bf2f(gv[i][g].y & 0xffff) * ab[i][0][4 * g + 2];
        tot[i][0][4 * g + 3] += bf2f(gv[i][g].y >> 16) * ab[i][0][4 * g + 3];
      }
    }
  }
  u16* M = (u16*)(p.ws + WS_R2);
  epi_each<2, 64>(tot, m0, n0, [&](f32x16& a, int rbase, int cbase) {
#pragma unroll
    for (int g = 0; g < 4; ++g) {
      uint2 v;
      v.x = pk2(a[4 * g], a[4 * g + 1]); v.y = pk2(a[4 * g + 2], a[4 * g + 3]);
      *(uint2*)(M + (size_t)(rbase + 8 * g + 4 * h + (lane & 3)) * LDH + cbase + (r & ~3)) = v;
    }
  });
}

DI void p6_item(const Params& p, int mt, int nt, char* smem, bool hn, int nmt, int nnt, bool* primed) {
  const int m0 = mt * 192, n0 = nt * 128;
  f32x16 acc[3][2];
  zero_acc(acc);
  gemm_kloop<3, 128>((const u16*)(p.ws + WS_R2) + (size_t)m0 * LDH, LDH, (const u16*)(p.ws + WS_WB) + WB_OUT + (size_t)n0 * LDH, LDH, 1024, smem, acc,
                     hn ? GNext{(const u16*)(p.ws + WS_R2) + (size_t)nmt * 192 * LDH, (const u16*)(p.ws + WS_WB) + WB_OUT + (size_t)nnt * 128 * LDH} : GNext{nullptr, nullptr}, primed);
  u16* Y = (u16*)(p.ws + WS_R1);
  const int lane = tidx() & 63, r = lane & 31, h = lane >> 5;
  epi_each<3, 128>(acc, m0, n0, [&](f32x16& a, int rbase, int cbase) {
#pragma unroll
    for (int reg = 0; reg < 16; ++reg) Y[(size_t)(rbase + crow(reg, h)) * 1024 + cbase + r] = f2bf(a[reg]);
  });
}
DI void p8_item(const Params& p, int mt, int nt, char* smem, bool hn, int nmt, int nnt, bool* primed) {
  const int m0 = mt * 192, n0 = nt * 128;
  f32x16 acc[3][2];
  zero_acc(acc);
  gemm_kloop<3, 128>((const u16*)(p.ws + WS_H) + (size_t)m0 * LDH, LDH, (const u16*)(p.ws + WS_WB) + WB_FF1 + (size_t)n0 * LDH, LDH, 1024, smem, acc,
                     hn ? GNext{(const u16*)(p.ws + WS_H) + (size_t)nmt * 192 * LDH, (const u16*)(p.ws + WS_WB) + WB_FF1 + (size_t)nnt * 128 * LDH} : GNext{nullptr, nullptr}, primed);
  u16* U = (u16*)(p.ws + WS_R1);
  const int lane = tidx() & 63, r = lane & 31, h = lane >> 5;
  epi_each<3, 128>(acc, m0, n0, [&](f32x16& a, int rbase, int cbase) {
#pragma unroll
    for (int reg = 0; reg < 16; ++reg) {
      float v = fmaxf(a[reg], 0.f);
      U[(size_t)(rbase + crow(reg, h)) * LDU + cbase + r] = f2bf(v * v);
    }
  });
}
DI void p9_item(const Params& p, int mt, int nt, char* smem, bool hn, int nmt, int nnt, bool* primed) {
  const int m0 = mt * 192, n0 = nt * 128;
  f32x16 acc[3][2];
  zero_acc(acc);
  gemm_kloop<3, 128>((const u16*)(p.ws + WS_R1) + (size_t)m0 * LDU, LDU, (const u16*)(p.ws + WS_WB) + WB_FF2 + (size_t)n0 * LDU, LDU, 4096, smem, acc,
                     hn ? GNext{(const u16*)(p.ws + WS_R1) + (size_t)nmt * 192 * LDU, (const u16*)(p.ws + WS_WB) + WB_FF2 + (size_t)nnt * 128 * LDU} : GNext{nullptr, nullptr}, primed);
  u16* F = (u16*)(p.ws + WS_R2);
  const int lane = tidx() & 63, r = lane & 31, h = lane >> 5;
  epi_each<3, 128>(acc, m0, n0, [&](f32x16& a, int rbase, int cbase) {
#pragma unroll
    for (int reg = 0; reg < 16; ++reg) F[(size_t)(rbase + crow(reg, h)) * 1024 + cbase + r] = f2bf(a[reg]);
  });
}

constexpr int NPHASE = 24;
DI void run_pre(const Params& p, int ph, int bid, int nb, char* smem) {
  if (ph == 0) {
    const int n = CONV_ITEMS + 1536 + 64;
    for (int it = bid; it < n; it += nb) {
      if (it < 1536) mod_item(p, it, smem);
      else if (it < 1600) misc_item(p, it - 1536);
      else convert_item(p, 0, it - 1600, smem);
    }
  } else {
    for (int it = bid; it < T / 8; it += nb) rowwise_item(p, 0, 0, it);
  }
}
template <int S>
DI void run_lp(const Params& p, int l, int bid, int nb, char* smem) {
  if constexpr (S == 0) { bool primed = false; for_tiles(64, 22, bid, nb, [&](int mt, int nt, bool hn, int a, int b) { p1_item(p, l, mt, nt, smem, hn, a, b, &primed); }); }
  if constexpr (S == 1) {
    for (int it = bid; it < 768; it += nb) m1_item(p, l, it, smem);
    int v = (bid - 768) % nb; if (v < 0) v += nb;
    for (int it = v; it < 3072 + 512; it += nb) {
      if (it < 3072) prep_token(p, l, it * 4 + (tidx() >> 6));
      else prep_cached(p, l, (it - 3072) * 4 + (tidx() >> 6));
    }
  }
  if constexpr (S == 2) {
    for (int it = bid; it < 288 + 448; it += nb) p3_item(p, l, it, smem);
    int v = (bid - 736) % nb; if (v < 0) v += nb;
    for (int it = v; it < 768; it += nb) scan_item(p, l, it);
  }
  if constexpr (S == 3) {
    auto vb = [&](int off) { int v = (bid - off) % nb; return v < 0 ? v + nb : v; };
    for (int it = vb(0); it < 256; it += nb) mla_item(p, it, smem);
    for (int it = vb(256); it < 256; it += nb) diff_item(p, l, it, smem);
    for (int it = vb(512); it < 768; it += nb) m3_item(p, l, it, smem);
    for (int it = vb(1280); it < 384; it += nb) gmlp_item(p, l, it, smem);
    for (int it = vb(1664); it < 128; it += nb) mla_item(p, it + 256, smem);
    for (int it = vb(1792); it < 128; it += nb) diff_item(p, l, it + 256, smem);
  }
  if constexpr (S == 4) { bool primed = false; for_tiles(64, 32, bid, nb, [&](int mt, int nt, bool hn, int a, int b) { p5a_item(p, l, mt, nt, smem, hn, a, b, &primed); }); }
  if constexpr (S == 10) { bool primed = false; for_tiles(96, 16, bid, nb, [&](int mt, int nt, bool hn, int a, int b) { p5b_item(p, mt, nt, smem, hn, a, b, &primed); }); }
  if constexpr (S == 5) { bool primed = false; for_tiles(64, 8, bid, nb, [&](int mt, int nt, bool hn, int a, int b) { p6_item(p, mt, nt, smem, hn, a, b, &primed); }); }
  if constexpr (S == 6) { for (int it = bid; it < T / 8; it += nb) rowwise_item(p, l, 1, it); }
  if constexpr (S == 7) { bool primed = false; for_tiles(64, 32, bid, nb, [&](int mt, int nt, bool hn, int a, int b) { p8_item(p, mt, nt, smem, hn, a, b, &primed); }); }
  if constexpr (S == 8) { bool primed = false; for_tiles(64, 8, bid, nb, [&](int mt, int nt, bool hn, int a, int b) { p9_item(p, mt, nt, smem, hn, a, b, &primed); }); }
  if constexpr (S == 9) {
    for (int it = bid; it < T / 8; it += nb) rowwise_item(p, l, 2, it);
    if (l + 1 < 2) {
      int v = (bid - T / 8) % nb; if (v < 0) v += nb;
      for (int it = v; it < CONV_ITEMS; it += nb) convert_item(p, l + 1, it, smem);
    }
  }
}
DI void run_phase(const Params& p, int ph, int bid, int nb, char* smem) {
  if (ph < 2) { run_pre(p, ph, bid, nb, smem); return; }
  const int l = (ph - 2) / 11, s = (ph - 2) % 11;
  switch (s) {
    case 0: run_lp<0>(p, l, bid, nb, smem); break;
    case 1: run_lp<1>(p, l, bid, nb, smem); break;
    case 2: run_lp<2>(p, l, bid, nb, smem); break;
    case 3: run_lp<3>(p, l, bid, nb, smem); break;
    case 4: run_lp<4>(p, l, bid, nb, smem); break;
    case 5: run_lp<10>(p, l, bid, nb, smem); break;
    case 6: run_lp<5>(p, l, bid, nb, smem); break;
    case 7: run_lp<6>(p, l, bid, nb, smem); break;
    case 8: run_lp<7>(p, l, bid, nb, smem); break;
    case 9: run_lp<8>(p, l, bid, nb, smem); break;
    case 10: run_lp<9>(p, l, bid, nb, smem); break;
  }
}

#if MEGA
#define XB_TMO      128
#define XB_XCNT(j)  (256  + 64 * (j))
#define XB_XSUB(j)  (1280 + 64 * (j))
#define XB_XGEN(j)  (2304 + 64 * (j))
#define XB_TOP      3328
#define XB_TOPGEN   3392
#define XCD_BAR_WORDS 3456
#define XB_SPIN_CAP (1u << 18)
#define LAS __attribute__((address_space(3)))

__device__ __forceinline__ unsigned xb_ld(unsigned* p)              { return __hip_atomic_load(p, __ATOMIC_RELAXED, __HIP_MEMORY_SCOPE_AGENT); }
__device__ __forceinline__ unsigned xb_add(unsigned* p, unsigned v) { return __hip_atomic_fetch_add(p, v, __ATOMIC_RELAXED, __HIP_MEMORY_SCOPE_AGENT); }
__device__ __forceinline__ unsigned xb_xcc_id() { return (unsigned)__builtin_amdgcn_s_getreg((3 << 11) | 20) & 0xFu; }
#define XB_SPIN(cond, bar) do { unsigned _sp = 0; while (cond) { __builtin_amdgcn_s_sleep(1); \
    if ((++_sp & 255u) == 0u) { if (xb_ld(&(bar)[XB_TMO])) break; if (_sp > XB_SPIN_CAP) { atomicAdd(&(bar)[XB_TMO], 1u); break; } } } } while (0)

struct XcdBarrier {
    unsigned* bar; unsigned x;
    unsigned st[2];
};

__device__ __forceinline__ XcdBarrier xcd_barrier_post(unsigned* bar) {
    XcdBarrier b; b.bar = bar; b.x = xb_xcc_id(); b.st[0] = 0u; b.st[1] = 0u;
    if (threadIdx.x == 0) (void)xb_add(&bar[XB_XCNT(b.x)], 1u);
    return b;
}
__device__ __forceinline__ void xcd_barrier_complete(unsigned* bar, unsigned x, unsigned& nloc, unsigned& nx) {
    const unsigned G = gridDim.x * gridDim.y * gridDim.z;
    unsigned sum, cnt, mine, sp = 0u;
    for (;;) {
        sum = 0u; cnt = 0u; mine = 0u;
#pragma unroll
        for (unsigned j = 0; j < 16; ++j) { const unsigned c = xb_ld(&bar[XB_XCNT(j)]); sum += c; cnt += (c > 0u) ? 1u : 0u; mine = (j == x) ? c : mine; }
        if (sum == G) break;
        __builtin_amdgcn_s_sleep(1);
        if ((++sp & 255u) == 0u) { if (xb_ld(&bar[XB_TMO])) break; if (sp > XB_SPIN_CAP) { atomicAdd(&bar[XB_TMO], 1u); break; } }
    }
    nloc = mine > 0u ? mine : 1u; nx = cnt > 0u ? cnt : 1u;
}

__device__ __forceinline__ void xcd_barrier(XcdBarrier& b) {
    asm volatile("s_waitcnt vmcnt(0)" ::: "memory");
    __syncthreads();
    if (threadIdx.x == 0) {
        unsigned* bar = b.bar;
        __builtin_amdgcn_s_waitcnt(0);
        unsigned nloc = b.st[0], nx = b.st[1];
        if (nloc == 0u) { xcd_barrier_complete(bar, b.x, nloc, nx); b.st[0] = nloc; b.st[1] = nx; }
        const unsigned old = xb_add(&bar[XB_XSUB(b.x)], 1u);
        const unsigned gen = old / nloc;
        if (old + 1u == (gen + 1u) * nloc) {
            __builtin_amdgcn_fence(__ATOMIC_RELEASE, "agent");
            asm volatile("s_waitcnt vmcnt(0)" ::: "memory");
            const unsigned og = xb_add(&bar[XB_TOP], 1u);
            const unsigned tg = og / nx;
            if (og + 1u == (tg + 1u) * nx) xb_add(&bar[XB_TOPGEN], 1u);
            else XB_SPIN(xb_ld(&bar[XB_TOPGEN]) == tg, bar);
            __builtin_amdgcn_fence(__ATOMIC_ACQUIRE, "agent");
            xb_add(&bar[XB_XGEN(b.x)], 1u);
            asm volatile("s_waitcnt vmcnt(0)" ::: "memory");
        } else {
            XB_SPIN(xb_ld(&bar[XB_XGEN(b.x)]) == gen, bar);
            __builtin_amdgcn_fence(__ATOMIC_ACQUIRE, "agent");
            asm volatile("s_waitcnt vmcnt(0)" ::: "memory");
        }
    }
    __syncthreads();
}

__global__ void __launch_bounds__(256, 2) mega_kernel(Params p) {
  __shared__ __attribute__((aligned(16))) char smem[SMEM_BYTES];
  cg::grid_group grid = cg::this_grid();
  const int bid = blockIdx.x, nb = gridDim.x;
  XcdBarrier xb = xcd_barrier_post((unsigned*)(p.ws + WS_BAR));
  if (p.ws == nullptr) grid.sync();
  run_pre(p, 0, bid, nb, smem); xcd_barrier(xb);
  run_pre(p, 1, bid, nb, smem); xcd_barrier(xb);
#pragma unroll 1
  for (int l = 0; l < 2; ++l) {
    run_lp<0>(p, l, bid, nb, smem); xcd_barrier(xb);
    run_lp<1>(p, l, bid, nb, smem); xcd_barrier(xb);
    run_lp<2>(p, l, bid, nb, smem); xcd_barrier(xb);
    run_lp<3>(p, l, bid, nb, smem); xcd_barrier(xb);
    run_lp<4>(p, l, bid, nb, smem); xcd_barrier(xb);
    run_lp<10>(p, l, bid, nb, smem); xcd_barrier(xb);
    run_lp<5>(p, l, bid, nb, smem); xcd_barrier(xb);
    run_lp<6>(p, l, bid, nb, smem); xcd_barrier(xb);
    run_lp<7>(p, l, bid, nb, smem); xcd_barrier(xb);
    run_lp<8>(p, l, bid, nb, smem); xcd_barrier(xb);
    run_lp<9>(p, l, bid, nb, smem);
    if (l == 0) xcd_barrier(xb);
  }
}
#else
__global__ void __launch_bounds__(256, 2) phase_kernel(Params p, int ph) {
  __shared__ __attribute__((aligned(16))) char smem[SMEM_BYTES];
  run_phase(p, ph, blockIdx.x, gridDim.x, smem);
}
#endif

extern "C" void kernel_launch(void* const* d_in, const int* in_sizes, int n_in, void* d_out, int out_size, void* d_ws,
                              size_t ws_size, hipStream_t stream) {
  Params p{};
  for (int i = 0; i < 32; ++i) p.in[i] = (const float*)d_in[i];
  p.out = (float*)d_out;
  p.ws = (char*)d_ws;
  static int grid_blocks = 0;
  if (!grid_blocks) {
    int dev = 0, cus = 0, per_cu = 0;
    hipGetDevice(&dev);
    hipDeviceGetAttribute(&cus, hipDeviceAttributeMultiprocessorCount, dev);
#if MEGA
    hipOccupancyMaxActiveBlocksPerMultiprocessor(&per_cu, mega_kernel, 256, 0);
#else
    hipOccupancyMaxActiveBlocksPerMultiprocessor(&per_cu, phase_kernel, 256, 0);
#endif
    if (per_cu > 2) per_cu = 2;
    if (per_cu < 1) per_cu = 1;
    grid_blocks = cus * per_cu;
  }
  hipMemsetAsync((char*)d_ws + WS_R3 + R3_MOD, 0, (size_t)2 * 9 * 6144 * 4, stream);
#if MEGA
  hipMemsetAsync((char*)d_ws + WS_BAR, 0, BAR_BYTES, stream);
  void* args[] = {&p};
  hipError_t e = hipLaunchCooperativeKernel((void*)mega_kernel, dim3(grid_blocks), dim3(256), args, 0, stream);
  if (e != hipSuccess) fprintf(stderr, "cooperative launch failed: %s (grid %d)\n", hipGetErrorString(e), grid_blocks);
#else
  for (int ph = 0; ph < NPHASE; ++ph) {
    phase_kernel<<<grid_blocks, 256, 0, stream>>>(p, ph);
    if ((DUPMASK >> ph) & 1) phase_kernel<<<grid_blocks, 256, 0, stream>>>(p, ph);
  }
#endif
}

#ifdef ANALYZE
template <int PH> __global__ void __launch_bounds__(256, 2) an_kernel(Params p) {
  __shared__ __attribute__((aligned(16))) char smem[SMEM_BYTES];
  run_phase(p, PH, blockIdx.x, gridDim.x, smem);
}
template __global__ void an_kernel<0>(Params);
template __global__ void an_kernel<1>(Params);
template __global__ void an_kernel<2>(Params);
template __global__ void an_kernel<3>(Params);
template __global__ void an_kernel<4>(Params);
template __global__ void an_kernel<5>(Params);
template __global__ void an_kernel<6>(Params);
template __global__ void an_kernel<7>(Params);
template __global__ void an_kernel<8>(Params);
template __global__ void an_kernel<9>(Params);
template __global__ void an_kernel<10>(Params);
template __global__ void an_kernel<11>(Params);
#endif
#ifdef ANALYZE
template <int W> __global__ void __launch_bounds__(256, 2) an4_kernel(Params p) {
  __shared__ __attribute__((aligned(16))) char smem[SMEM_BYTES];
  for (int it = blockIdx.x; it < 256; it += gridDim.x) {
    if (W == 0) mla_item(p, it, smem);
    if (W == 1) diff_item(p, 0, it, smem);
    if (W == 2) m3_item(p, 0, it, smem);
    if (W == 3) gmlp_item(p, 0, it, smem);
  }
}
template __global__ void an4_kernel<0>(Params);
template __global__ void an4_kernel<1>(Params);
template __global__ void an4_kernel<2>(Params);
template __global__ void an4_kernel<3>(Params);
#endif
```

```cpp
#include <hip/hip_runtime.h>
#include <hip/hip_cooperative_groups.h>
#include <cstdio>
#include <cstdint>
namespace cg = cooperative_groups;

#ifndef MEGA
#define MEGA 1
#endif
#ifndef DUPMASK
#define DUPMASK 0u
#endif

#define DI __device__ __forceinline__
typedef unsigned short u16;
typedef __attribute__((ext_vector_type(8))) short bf16x8;
typedef __attribute__((ext_vector_type(4))) short s16x4;
typedef __attribute__((ext_vector_type(16))) float f32x16;
typedef __attribute__((ext_vector_type(2))) __bf16 bf2_t;
typedef __attribute__((ext_vector_type(4))) unsigned u32x4;
typedef __attribute__((ext_vector_type(2))) unsigned u32x2;
#define MFMA32(a, b, c) __builtin_amdgcn_mfma_f32_32x32x16_bf16((a), (b), (c), 0, 0, 0)

constexpr int D = 1024, TC = 4096, TL = 8192, T = 12288, KEYROWS = 14336;
constexpr int ZLD = 2736;
constexpr int ZB = 416, ZC = 928, ZD = 1968;
constexpr int NWIN = 2816;
constexpr int LDH = 1088, LDU = 4160;
constexpr float EPS = 1e-6f;
constexpr float LOG2E = 1.4426950408889634f;
constexpr int NCHUNK = 192;

constexpr size_t O_YP = 0, O_YS = 4194304, O_CKV = 12582912, O_KR = 13631488, O_DK = 13893632, O_DV = 15990784,
                 O_C = 18087936, O_N = 19136512, O_M = 19152896;

constexpr size_t WB_IN = 0;
constexpr size_t WB_MG = WB_IN + (size_t)NWIN * LDH;
constexpr size_t WB_UQ = WB_MG + (size_t)4096 * LDH;
constexpr size_t WB_UKV = WB_UQ + (size_t)384 * 256;
constexpr size_t WB_BR = WB_UKV + (size_t)512 * 128;
constexpr size_t WB_OUT = WB_BR + (size_t)4 * 1024 * 256;
constexpr size_t WB_FF1 = WB_OUT + (size_t)1024 * LDH;
constexpr size_t WB_FF2 = WB_FF1 + (size_t)4096 * LDH;
constexpr size_t WB_WS = WB_FF2 + (size_t)1024 * LDU;
constexpr size_t WB_TOTAL = WB_WS + (size_t)4 * 128 * 128;

constexpr size_t al256(size_t x) { return (x + 255) & ~(size_t)255; }
constexpr size_t WS_WB = 0;
constexpr size_t WS_H = al256(WS_WB + WB_TOTAL * 2);
constexpr size_t WS_R1 = al256(WS_H + (size_t)T * LDH * 2);
constexpr size_t R1_Z = 0;
constexpr size_t R1_YMIX = al256((size_t)T * ZLD * 2);
constexpr size_t R1_SIZE = (size_t)T * LDU * 2;
static_assert(R1_YMIX + (size_t)T * LDH * 2 <= R1_SIZE, "R1 overflow");
constexpr size_t WS_R2 = al256(WS_R1 + R1_SIZE);
constexpr size_t R2_CQ = 0;
constexpr size_t R2_QMLA = al256(R2_CQ + (size_t)T * 256 * 2);
constexpr size_t R2_CKV = al256(R2_QMLA + (size_t)T * 384 * 2);
constexpr size_t R2_KMLA = al256(R2_CKV + (size_t)KEYROWS * 128 * 2);
constexpr size_t R2_VMLA = al256(R2_KMLA + (size_t)KEYROWS * 384 * 2);
constexpr size_t R2_END = al256(R2_VMLA + (size_t)KEYROWS * 256 * 2);
constexpr size_t R2_G3 = al256((size_t)T * LDH * 2);
constexpr size_t R2_SIZE = R2_G3 + (size_t)T * 1024 * 2;
static_assert(R2_END <= R2_SIZE, "R2 overflow");
constexpr size_t WS_R3 = al256(WS_R2 + R2_SIZE);
constexpr size_t R3_DC = 0;
constexpr size_t R3_DN = al256(R3_DC + (size_t)2 * 4 * NCHUNK * 4096 * 4);
constexpr size_t R3_CHB = al256(R3_DN + (size_t)2 * 4 * NCHUNK * 64 * 4);
constexpr size_t R3_CHM = al256(R3_CHB + (size_t)2 * 4 * NCHUNK * 4);
constexpr size_t R3_MST = al256(R3_CHM + (size_t)2 * 4 * NCHUNK * 4);
constexpr size_t R3_GATES = al256(R3_MST + (size_t)2 * 4 * NCHUNK * 4);
constexpr size_t R3_GB = al256(R3_GATES + (size_t)T * 16 * 4);
constexpr size_t R3_GI = al256(R3_GB + (size_t)8 * T * 4);
constexpr size_t R3_RSTDV = al256(R3_GI + (size_t)8 * T * 4);
constexpr size_t R3_MOD = al256(R3_RSTDV + (size_t)T * 4);
constexpr size_t R3_ROPE = al256(R3_MOD + (size_t)2 * 9 * 6144 * 4);
constexpr size_t R3_LAM = al256(R3_ROPE + (size_t)1024 * 16 * 8);
constexpr size_t R3_QD = al256(R3_LAM + 256);
constexpr size_t R3_KD = al256(R3_QD + (size_t)T * 256 * 2);
constexpr size_t R3_VD = al256(R3_KD + (size_t)KEYROWS * 256 * 2);
constexpr size_t R3_END = al256(R3_VD + (size_t)KEYROWS * 256 * 2);
constexpr size_t WS_BAR = WS_R3 + R3_END;
constexpr size_t BAR_BYTES = 16384;
constexpr size_t WS_TOTAL = WS_BAR + BAR_BYTES;
static_assert(WS_TOTAL <= (size_t)256 * 1024 * 1024, "workspace over 256 MiB");

struct Params {
  const float* in[32];
  float* out;
  char* ws;
};

constexpr int SMEM_BYTES = 2 * (192 + 128) * 128;

DI int tidx() { int t = __builtin_amdgcn_workitem_id_x(); asm volatile("" : "+v"(t)); return t; }
DI float bf2f(u16 v) { return __uint_as_float(((unsigned)v) << 16); }
DI unsigned pk2(float a, float b) { bf2_t v; v[0] = (__bf16)a; v[1] = (__bf16)b; return __builtin_bit_cast(unsigned, v); }
DI u16 f2bf(float a) { __bf16 v = (__bf16)a; return __builtin_bit_cast(u16, v); }
DI float wave_sum(float v) {
#pragma unroll
  for (int o = 32; o > 0; o >>= 1) v += __shfl_xor(v, o);
  return v;
}
DI float wave_max(float v) {
#pragma unroll
  for (int o = 32; o > 0; o >>= 1) v = fmaxf(v, __shfl_xor(v, o));
  return v;
}
DI float sigmoidf_(float x) { return 1.f / (1.f + __expf(-x)); }
DI int crow(int reg, int h) { return (reg & 3) + 8 * (reg >> 2) + 4 * h; }
DI void zero16(f32x16& a) {
#pragma unroll
  for (int i = 0; i < 16; ++i) a[i] = 0.f;
}
DI bf16x8 pack8(const f32x16& x, int s) {
  uint4 p;
  p.x = pk2(x[8 * s + 0], x[8 * s + 1]); p.y = pk2(x[8 * s + 2], x[8 * s + 3]);
  p.z = pk2(x[8 * s + 4], x[8 * s + 5]); p.w = pk2(x[8 * s + 6], x[8 * s + 7]);
  return __builtin_bit_cast(bf16x8, p);
}
DI float dpp_xor1(float v) { return __builtin_bit_cast(float, __builtin_amdgcn_update_dpp(0, __builtin_bit_cast(int, v), 0xB1, 0xF, 0xF, true)); }
DI float dpp_xor2(float v) { return __builtin_bit_cast(float, __builtin_amdgcn_update_dpp(0, __builtin_bit_cast(int, v), 0x4E, 0xF, 0xF, true)); }
DI void quad_tr(f32x16& a, int lane) {
  const bool o1 = lane & 1, o2 = lane & 2;
#pragma unroll
  for (int g = 0; g < 4; ++g) {
    float a0 = a[4 * g], a1 = a[4 * g + 1], a2 = a[4 * g + 2], a3 = a[4 * g + 3];
    float rv = dpp_xor1(o1 ? a0 : a1);
    if (o1) a0 = rv; else a1 = rv;
    rv = dpp_xor1(o1 ? a2 : a3);
    if (o1) a2 = rv; else a3 = rv;
    const float r0 = dpp_xor2(o2 ? a0 : a2), r1 = dpp_xor2(o2 ? a1 : a3);
    if (o2) { a0 = r0; a1 = r1; } else { a2 = r0; a3 = r1; }
    a[4 * g] = a0; a[4 * g + 1] = a1; a[4 * g + 2] = a2; a[4 * g + 3] = a3;
  }
}
DI int midx_of(int row) { return row < TC ? 0 : 1 + ((row - TC) >> 10); }
DI int keyrow_of(int row) { return row < TC ? row : TC + ((row - TC) >> 10) * 1280 + 256 + ((row - TC) & 1023); }

struct GNext { const u16* A; const u16* B; };
template <int TM, int BN>
DI void gemm_kloop(const u16* __restrict__ A, int lda, const u16* __restrict__ Bt, int ldb, int K, char* smem,
                   f32x16 (&acc)[TM][BN / 64], GNext nx = GNext{nullptr, nullptr}, bool* primed = nullptr) {
  constexpr int BM = 64 * TM, TN = BN / 64;
  constexpr int NA = BM / 32, NBI = BN / 32;
  constexpr int STGB = (BM + BN) * 128;
  const int tid = tidx(), lane = tid & 63, w = tid >> 6, wm = w >> 1, wn = w & 1, r = lane & 31, h = lane >> 5;
  const int gkc = ((tid & 7) ^ ((tid >> 4) & 7)) * 8;
  const u16* Ap = A + (size_t)(tid >> 3) * lda + gkc;
  const u16* Bp = Bt + (size_t)(tid >> 3) * ldb + gkc;
  const int nk = K >> 6;
  const bool hasnext = nx.A != nullptr;
  const u16* nAp = hasnext ? nx.A + (size_t)(tid >> 3) * lda + gkc : Ap;
  const u16* nBp = hasnext ? nx.B + (size_t)(tid >> 3) * ldb + gkc : Bp;
  auto issue_from = [&](const u16* ap, const u16* bp, int stg, int idx) {
    char* dst = smem + stg * STGB + tid * 16;
    if (idx < NA)
      __builtin_amdgcn_global_load_lds((const unsigned*)(ap + (size_t)(idx * 32) * lda), (__attribute__((address_space(3))) unsigned*)(dst + idx * 4096), 16, 0, 0);
    else
      __builtin_amdgcn_global_load_lds((const unsigned*)(bp + (size_t)((idx - NA) * 32) * ldb), (__attribute__((address_space(3))) unsigned*)(dst + BM * 128 + (idx - NA) * 4096), 16, 0, 0);
  };
  const int sw = (r >> 1) & 7;
  const unsigned lbase = (unsigned)(size_t)smem;
  const unsigned abase = lbase + (wm * (BM / 2) + r) * 128;
  const unsigned bbase = lbase + BM * 128 + (wn * (BN / 2) + r) * 128;
  if (!(primed && *primed)) {
    asm volatile("s_waitcnt vmcnt(0)" ::: "memory");
    __builtin_amdgcn_s_barrier();
#pragma unroll
    for (int i = 0; i < NA + NBI; ++i) issue_from(Ap, Bp, 0, i);
  }
  if (primed) *primed = hasnext;
  for (int kt = 0; kt < nk; ++kt) {
    asm volatile("s_waitcnt vmcnt(0)" ::: "memory");
    __builtin_amdgcn_s_barrier();
    const bool last = kt + 1 >= nk;
    const bool more = !last || hasnext;
    const u16* sAp = last ? nAp : Ap + (kt + 1) * 64;
    const u16* sBp = last ? nBp : Bp + (kt + 1) * 64;
    const unsigned so = (kt & 1) * STGB;
    bf16x8 af[2][2][TM], bfr[2][2][TN];
#pragma unroll
    for (int hf = 0; hf < 2; ++hf) {
#pragma unroll
      for (int kk = 0; kk < 2; ++kk) {
        const unsigned co = (((hf * 2 + kk) * 2 + h) ^ sw) * 16 + so;
#pragma unroll
        for (int i = 0; i < TM; ++i) asm volatile("ds_read_b128 %0, %1" : "=v"(af[hf][kk][i]) : "v"(abase + co + i * 4096));
#pragma unroll
        for (int j = 0; j < TN; ++j) asm volatile("ds_read_b128 %0, %1" : "=v"(bfr[hf][kk][j]) : "v"(bbase + co + j * 4096));
      }
    }
    asm volatile("s_waitcnt lgkmcnt(%0)" ::"n"(2 * (TM + TN)) : "memory");
#pragma unroll
    for (int kk = 0; kk < 2; ++kk) {
#pragma unroll
      for (int i = 0; i < TM; ++i) asm volatile("" : "+v"(af[0][kk][i]));
#pragma unroll
      for (int j = 0; j < TN; ++j) asm volatile("" : "+v"(bfr[0][kk][j]));
    }
    __builtin_amdgcn_s_setprio(1);
#pragma unroll
    for (int kk = 0; kk < 2; ++kk)
#pragma unroll
      for (int i = 0; i < TM; ++i)
#pragma unroll
        for (int j = 0; j < TN; ++j) {
          acc[i][j] = MFMA32(af[0][kk][i], bfr[0][kk][j], acc[i][j]);
          constexpr int dummy = 0; (void)dummy;
          const int m = (kk * TM + i) * TN + j;
          if (m < NA + NBI) {
            __builtin_amdgcn_sched_barrier(0);
            if (more) issue_from(sAp, sBp, (kt + 1) & 1, m);
            __builtin_amdgcn_sched_barrier(0);
          }
        }
    if (more) {
#pragma unroll
      for (int m = 2 * TM * TN; m < NA + NBI; ++m) issue_from(sAp, sBp, (kt + 1) & 1, m);
    }
    asm volatile("s_waitcnt lgkmcnt(0)" ::: "memory");
#pragma unroll
    for (int kk = 0; kk < 2; ++kk) {
#pragma unroll
      for (int i = 0; i < TM; ++i) asm volatile("" : "+v"(af[1][kk][i]));
#pragma unroll
      for (int j = 0; j < TN; ++j) asm volatile("" : "+v"(bfr[1][kk][j]));
    }
#pragma unroll
    for (int kk = 0; kk < 2; ++kk)
#pragma unroll
      for (int i = 0; i < TM; ++i)
#pragma unroll
        for (int j = 0; j < TN; ++j) acc[i][j] = MFMA32(af[1][kk][i], bfr[1][kk][j], acc[i][j]);
    __builtin_amdgcn_s_setprio(0);
  }
}

template <int TM, int BN, class F>
DI void epi_each(f32x16 (&acc)[TM][BN / 64], int m0, int n0, F f) {
  const int w = tidx() >> 6, wm = w >> 1, wn = w & 1;
#pragma unroll
  for (int i = 0; i < TM; ++i)
#pragma unroll
    for (int j = 0; j < BN / 64; ++j) f(acc[i][j], m0 + wm * (32 * TM) + i * 32, n0 + wn * (BN / 2) + j * 32);
}
template <int TM, int TN>
DI void zero_acc(f32x16 (&acc)[TM][TN]) {
#pragma unroll
  for (int i = 0; i < TM; ++i)
#pragma unroll
    for (int j = 0; j < TN; ++j) zero16(acc[i][j]);
}
template <class F>
DI void for_tiles(int NM, int NN, int bid, int nb, F f) {
  if ((nb & 7) == 0 && (NM & 7) == 0) {
    const int x = bid & 7, ns = nb >> 3, tot = (NM >> 3) * NN;
    const int nmx = NM >> 3;
    for (int j = bid >> 3; j < tot; j += ns) {
      const int jn = j + ns;
      f((j % nmx) * 8 + x, j / nmx, jn < tot, (jn % nmx) * 8 + x, jn / nmx);
    }
  } else {
    for (int it = bid; it < NM * NN; it += nb) { const int itn = it + nb; f(it / NN, it % NN, itn < NM * NN, itn / NN, itn % NN); }
  }
}

DI bool tjob(int& t, int K, int N, int Npad, int ldd, const float* __restrict__ src, u16* __restrict__ dst, char* smem) {
  const int tk = K / 64, tn = Npad / 64;
  if (t >= tk * tn) { t -= tk * tn; return false; }
  float* tile = (float*)smem;
  const int k0 = (t / tn) * 64, n0 = (t % tn) * 64;
  const int tid = tidx();
  __syncthreads();
#pragma unroll
  for (int i = 0; i < 4; ++i) {
    const int k = i * 16 + (tid >> 4), n = n0 + (tid & 15) * 4;
    float4 v = make_float4(0.f, 0.f, 0.f, 0.f);
    if (n + 3 < N) v = *(const float4*)(src + (size_t)(k0 + k) * N + n);
    else {
      if (n < N) v.x = src[(size_t)(k0 + k) * N + n];
      if (n + 1 < N) v.y = src[(size_t)(k0 + k) * N + n + 1];
      if (n + 2 < N) v.z = src[(size_t)(k0 + k) * N + n + 2];
    }
    float* tp = tile + k * 65 + (tid & 15) * 4;
    tp[0] = v.x; tp[1] = v.y; tp[2] = v.z; tp[3] = v.w;
  }
  __syncthreads();
#pragma unroll
  for (int i = 0; i < 2; ++i) {
    const int n = i * 32 + (tid >> 3), kc = (tid & 7) * 8;
    uint4 o;
    o.x = pk2(tile[(kc + 0) * 65 + n], tile[(kc + 1) * 65 + n]);
    o.y = pk2(tile[(kc + 2) * 65 + n], tile[(kc + 3) * 65 + n]);
    o.z = pk2(tile[(kc + 4) * 65 + n], tile[(kc + 5) * 65 + n]);
    o.w = pk2(tile[(kc + 6) * 65 + n], tile[(kc + 7) * 65 + n]);
    *(uint4*)(dst + (size_t)(n0 + n) * ldd + k0 + kc) = o;
  }
  return true;
}
constexpr int CONV_ITEMS = 16 * 44 + 16 * 64 + 4 * 6 + 2 * 8 + 4 * 4 * 16 + 16 * 16 + 16 * 64 + 64 * 16 + 16;
DI void convert_item(const Params& p, int l, int t, char* smem) {
  u16* wb = (u16*)(p.ws + WS_WB);
  if (tjob(t, 1024, 2736, NWIN, LDH, p.in[14] + (size_t)l * 1024 * 2736, wb + WB_IN, smem)) return;
  if (tjob(t, 1024, 4096, 4096, LDH, p.in[27] + (size_t)l * 1024 * 4096, wb + WB_MG, smem)) return;
  if (tjob(t, 256, 384, 384, 256, p.in[16] + (size_t)l * 256 * 384, wb + WB_UQ, smem)) return;
  if (tjob(t, 128, 512, 512, 128, p.in[18] + (size_t)l * 128 * 512, wb + WB_UKV, smem)) return;
#pragma unroll 1
  for (int n = 0; n < 4; ++n)
    if (tjob(t, 256, 1024, 1024, 256, p.in[26] + ((size_t)l * 4 + n) * 256 * 1024, wb + WB_BR + (size_t)n * 1024 * 256, smem)) return;
  if (tjob(t, 1024, 1024, 1024, LDH, p.in[29] + (size_t)l * 1024 * 1024, wb + WB_OUT, smem)) return;
  if (tjob(t, 1024, 4096, 4096, LDH, p.in[30] + (size_t)l * 1024 * 4096, wb + WB_FF1, smem)) return;
  if (tjob(t, 4096, 1024, 1024, LDU, p.in[31] + (size_t)l * 4096 * 1024, wb + WB_FF2, smem)) return;
  const float* src = p.in[20] + (size_t)l * 65536 + (size_t)t * 4096;
  u16* dst = wb + WB_WS + (size_t)t * 4096;
  for (int i = tidx(); i < 4096; i += 256) dst[i] = f2bf(src[i]);
}

DI void mod_item(const Params& p, int it, char* smem) {
  const int l = it / 768, rem = it % 768, cb = rem >> 3, kp = rem & 7;
  float* sc = (float*)smem;
  float* red = sc + 9 * 128;
  const int tid = tidx();
  __syncthreads();
  for (int i = tid; i < 9 * 128; i += 256) {
    int ci = i >> 7, k = kp * 128 + (i & 127);
    float x = (ci == 0) ? p.in[10][k] : p.in[9][(ci - 1) * 1024 + k];
    sc[i] = x / (1.f + __expf(-x));
  }
  __syncthreads();
  const int col = cb * 64 + (tid & 63), kg = tid >> 6;
  const float* wm = p.in[11] + (size_t)l * 1024 * 6144 + (size_t)(kp * 128) * 6144 + col;
  float acc[9];
#pragma unroll
  for (int c = 0; c < 9; ++c) acc[c] = 0.f;
#pragma unroll 8
  for (int k = kg; k < 128; k += 4) {
    float wv = wm[(size_t)k * 6144];
#pragma unroll
    for (int c = 0; c < 9; ++c) acc[c] += sc[c * 128 + k] * wv;
  }
#pragma unroll
  for (int c = 0; c < 9; ++c) red[(kg * 9 + c) * 64 + (tid & 63)] = acc[c];
  __syncthreads();
  float* mod = (float*)(p.ws + WS_R3 + R3_MOD);
  for (int i = tid; i < 9 * 64; i += 256) {
    int c = i >> 6, cc = i & 63;
    float sm = red[(0 * 9 + c) * 64 + cc] + red[(1 * 9 + c) * 64 + cc] + red[(2 * 9 + c) * 64 + cc] + red[(3 * 9 + c) * 64 + cc];
    int cg_ = cb * 64 + cc;
    if (kp == 0) sm += p.in[12][(size_t)l * 6144 + cg_];
    atomicAdd(&mod[((size_t)l * 9 + c) * 6144 + cg_], sm);
  }
}
DI void misc_item(const Params& p, int it) {
  float2* rope = (float2*)(p.ws + WS_R3 + R3_ROPE);
  int idx = it * 256 + tidx();
  int pos = idx >> 4, i = idx & 15;
  float inv = expf(-logf(10000.f) * (float)(i & 7) / 8.f);
  float ang = (float)((i < 8) ? (pos >> 6) : (pos & 63)) * inv;
  float s, c;
  sincosf(ang, &s, &c);
  rope[idx] = make_float2(c, s);
  if (it == 0 && tidx() < 2) {
    int l = tidx();
    const float* lf = p.in[24] + l * 128;
    float a = 0.f, b = 0.f;
    for (int k = 0; k < 32; ++k) { a += lf[k] * lf[32 + k]; b += lf[64 + k] * lf[96 + k]; }
    float lam_init = 0.8f - 0.6f * expf(-0.3f * (float)l);
    float* lam = (float*)(p.ws + WS_R3 + R3_LAM);
    lam[l * 2] = expf(a) - expf(b) + lam_init;
    lam[l * 2 + 1] = lam_init;
  }
}

DI void rowwise_item(const Params& p, int l, int mode, int it) {
  constexpr int NR = 2;
  const int lane = tidx() & 63, w = tidx() >> 6;
  const float* mod = (const float*)(p.ws + WS_R3 + R3_MOD);
  int row[NR], ci[NR];
  float4 xv[NR][4];
#pragma unroll
  for (int q = 0; q < NR; ++q) { row[q] = it * 8 + q * 4 + w; ci[q] = midx_of(row[q]); }
  if (mode == 0) {
#pragma unroll
    for (int q = 0; q < NR; ++q) {
      const float* src = (row[q] < TC) ? p.in[0] + (size_t)row[q] * 1024 : p.in[1] + (size_t)(row[q] - TC) * 1024;
#pragma unroll
      for (int i = 0; i < 4; ++i) xv[q][i] = *(const float4*)(src + i * 256 + lane * 4);
    }
  } else {
    const float* ng = p.in[13] + ((size_t)l * 4 + (mode == 1 ? 1 : 3)) * 1024;
    float4 yv[NR][4];
    float ss[NR];
#pragma unroll
    for (int q = 0; q < NR; ++q) {
      const u16* Y = (mode == 1) ? (const u16*)(p.ws + WS_R1) + (size_t)row[q] * 1024 : (const u16*)(p.ws + WS_R2) + (size_t)row[q] * 1024;
      const float* X = (mode == 1 && l == 0)
                           ? ((row[q] < TC) ? p.in[0] + (size_t)row[q] * 1024 : p.in[1] + (size_t)(row[q] - TC) * 1024)
                           : p.out + (size_t)row[q] * 1024;
      ss[q] = 0.f;
#pragma unroll
      for (int i = 0; i < 4; ++i) {
        const uint2 yb = *(const uint2*)(Y + i * 256 + lane * 4);
        xv[q][i] = *(const float4*)(X + i * 256 + lane * 4);
        yv[q][i] = make_float4(bf2f(yb.x & 0xffff), bf2f(yb.x >> 16), bf2f(yb.y & 0xffff), bf2f(yb.y >> 16));
        ss[q] += yv[q][i].x * yv[q][i].x + yv[q][i].y * yv[q][i].y + yv[q][i].z * yv[q][i].z + yv[q][i].w * yv[q][i].w;
      }
    }
#pragma unroll
    for (int q = 0; q < NR; ++q) ss[q] = wave_sum(ss[q]);
#pragma unroll
    for (int q = 0; q < NR; ++q) {
      const float rs = rsqrtf(ss[q] * (1.f / 1024.f) + EPS);
      const float* gm = mod + ((size_t)l * 9 + ci[q]) * 6144 + (mode == 1 ? 2048 : 5120);
#pragma unroll
      for (int i = 0; i < 4; ++i) {
        const int c = i * 256 + lane * 4;
        float4 x0 = xv[q][i];
        float4 g = *(const float4*)(ng + c);
        float4 gg = *(const float4*)(gm + c);
        x0.x += gg.x * (yv[q][i].x * rs * g.x); x0.y += gg.y * (yv[q][i].y * rs * g.y);
        x0.z += gg.z * (yv[q][i].z * rs * g.z); x0.w += gg.w * (yv[q][i].w * rs * g.w);
        xv[q][i] = x0;
      }
    }
  }
  if (mode != 0) {
#pragma unroll
    for (int q = 0; q < NR; ++q) {
      float* X = p.out + (size_t)row[q] * 1024;
#pragma unroll
      for (int i = 0; i < 4; ++i) *(float4*)(X + i * 256 + lane * 4) = xv[q][i];
    }
  }
  int ln = l, ngi = 2, off_sh = 3072, off_sc = 4096;
  if (mode == 0) { ln = 0; ngi = 0; off_sh = 0; off_sc = 1024; }
  if (mode == 2) { ln = l + 1; ngi = 0; off_sh = 0; off_sc = 1024; }
  if (ln >= 2) return;
  float s2[NR];
#pragma unroll
  for (int q = 0; q < NR; ++q) {
    s2[q] = 0.f;
#pragma unroll
    for (int i = 0; i < 4; ++i) s2[q] += xv[q][i].x * xv[q][i].x + xv[q][i].y * xv[q][i].y + xv[q][i].z * xv[q][i].z + xv[q][i].w * xv[q][i].w;
  }
#pragma unroll
  for (int q = 0; q < NR; ++q) s2[q] = wave_sum(s2[q]);
  const float* ng = p.in[13] + ((size_t)ln * 4 + ngi) * 1024;
#pragma unroll
  for (int q = 0; q < NR; ++q) {
    const float rs = rsqrtf(s2[q] * (1.f / 1024.f) + EPS);
    const float* mm = mod + ((size_t)ln * 9 + ci[q]) * 6144;
    u16* H = (u16*)(p.ws + WS_H) + (size_t)row[q] * LDH;
#pragma unroll
    for (int i = 0; i < 4; ++i) {
      const int c = i * 256 + lane * 4;
      float4 g = *(const float4*)(ng + c);
      float4 sc = *(const float4*)(mm + off_sc + c);
      float4 sh = *(const float4*)(mm + off_sh + c);
      uint2 o;
      o.x = pk2(xv[q][i].x * rs * g.x * (1.f + sc.x) + sh.x, xv[q][i].y * rs * g.y * (1.f + sc.y) + sh.y);
      o.y = pk2(xv[q][i].z * rs * g.z * (1.f + sc.z) + sh.z, xv[q][i].w * rs * g.w * (1.f + sc.w) + sh.w);
      *(uint2*)(H + c) = o;
    }
  }
}

DI void p1_item(const Params& p, int l, int mt, int nt, char* smem, bool hn, int nmt, int nnt, bool* primed) {
  const int m0 = mt * 192, n0 = nt * 128;
  const u16* H = (const u16*)(p.ws + WS_H);
  const u16* W = (const u16*)(p.ws + WS_WB) + WB_IN;
  f32x16 acc[3][2];
  zero_acc(acc);
  gemm_kloop<3, 128>(H + (size_t)m0 * LDH, LDH, W + (size_t)n0 * LDH, LDH, 1024, smem, acc,
                     hn ? GNext{H + (size_t)nmt * 192 * LDH, W + (size_t)nnt * 128 * LDH} : GNext{nullptr, nullptr}, primed);
  u16* Z = (u16*)(p.ws + WS_R1 + R1_Z);
  float* gates = (float*)(p.ws + WS_R3 + R3_GATES);
  float* out = p.out;
  const int lane = tidx() & 63, r = lane & 31, h = lane >> 5;
  epi_each<3, 128>(acc, m0, n0, [&](f32x16& a, int rbase, int cbase) {
    quad_tr(a, lane);
    const int c0 = cbase + (r & ~3);
    if (c0 >= ZLD) return;
#pragma unroll
    for (int g = 0; g < 4; ++g) {
      const int row = rbase + 8 * g + 4 * h + (lane & 3);
      const float4 v = make_float4(a[4 * g], a[4 * g + 1], a[4 * g + 2], a[4 * g + 3]);
      uint2 zb; zb.x = pk2(v.x, v.y); zb.y = pk2(v.z, v.w);
      *(uint2*)(Z + (size_t)row * ZLD + c0) = zb;
      if (c0 >= 1952 && c0 < 1968) *(float4*)(gates + (size_t)row * 16 + (c0 - 1952)) = v;
      if (row < TC) {
        const int b = row >> 8, pos = row & 255;
        const size_t rb = ((size_t)(b * 2 + l) * 256 + pos);
        if (c0 >= 384 && c0 < 416) *(float4*)(out + O_KR + rb * 32 + (c0 - 384)) = v;
        else if (c0 >= 2224 && c0 < 2480) *(float4*)(out + O_DK + rb * 256 + (c0 - 2224)) = v;
        else if (c0 >= 2480) *(float4*)(out + O_DV + rb * 256 + (c0 - 2480)) = v;
      }
    }
  });
}

DI void prep_token(const Params& p, int l, int row) {
  const int lane = tidx() & 63;
  const u16* z = (const u16*)(p.ws + WS_R1 + R1_Z) + (size_t)row * ZLD;
  const bool lat = row >= TC;
  const int pos = lat ? ((row - TC) & 1023) : 0;
  const int kr_ = keyrow_of(row);
  const float2* rope = (const float2*)(p.ws + WS_R3 + R3_ROPE) + pos * 16;
  {
    uint2 v = *(const uint2*)(z + lane * 4);
    float x0 = bf2f(v.x & 0xffff), x1 = bf2f(v.x >> 16), x2 = bf2f(v.y & 0xffff), x3 = bf2f(v.y >> 16);
    float ss = wave_sum(x0 * x0 + x1 * x1 + x2 * x2 + x3 * x3);
    float rs = rsqrtf(ss * (1.f / 256.f) + EPS);
    float4 g = *(const float4*)(p.in[15] + l * 256 + lane * 4);
    uint2 o;
    o.x = pk2(x0 * rs * g.x, x1 * rs * g.y);
    o.y = pk2(x2 * rs * g.z, x3 * rs * g.w);
    *(uint2*)((u16*)(p.ws + WS_R2 + R2_CQ) + (size_t)row * 256 + lane * 4) = o;
  }
  {
    unsigned v = *(const unsigned*)(z + 256 + lane * 2);
    float x0 = bf2f(v & 0xffff), x1 = bf2f(v >> 16);
    float ss = wave_sum(x0 * x0 + x1 * x1);
    float rs = rsqrtf(ss * (1.f / 128.f) + EPS);
    float2 g = *(const float2*)(p.in[17] + l * 128 + lane * 2);
    float y0 = x0 * rs * g.x, y1 = x1 * rs * g.y;
    *(unsigned*)((u16*)(p.ws + WS_R2 + R2_CKV) + (size_t)kr_ * 128 + lane * 2) = pk2(y0, y1);
    if (!lat) {
      const int b = row >> 8, ps = row & 255;
      *(float2*)(p.out + O_CKV + ((size_t)(b * 2 + l) * 256 + ps) * 128 + lane * 2) = make_float2(y0, y1);
    }
  }
  if (lane < 16) {
    float x1 = bf2f(z[384 + lane]), x2 = bf2f(z[400 + lane]);
    if (lat) {
      float2 cs = rope[lane];
      float a = x1 * cs.x - x2 * cs.y, b = x1 * cs.y + x2 * cs.x;
      x1 = a; x2 = b;
    }
    u16* km = (u16*)(p.ws + WS_R2 + R2_KMLA) + (size_t)kr_ * 384;
    const u16 b1 = f2bf(x1), b2 = f2bf(x2);
#pragma unroll
    for (int hh = 0; hh < 4; ++hh) { km[hh * 96 + 64 + lane] = b1; km[hh * 96 + 80 + lane] = b2; }
  }
  {
    uint2 v = *(const uint2*)(z + 672 + lane * 4);
    float x0 = bf2f(v.x & 0xffff), x1 = bf2f(v.x >> 16), x2 = bf2f(v.y & 0xffff), x3 = bf2f(v.y >> 16);
    float ss = wave_sum(x0 * x0 + x1 * x1 + x2 * x2 + x3 * x3);
    if (lane == 0) ((float*)(p.ws + WS_R3 + R3_RSTDV))[row] = rsqrtf(ss * (1.f / 256.f) + EPS);
  }
  {
    u16* qd = (u16*)(p.ws + WS_R3 + R3_QD) + (size_t)row * 256;
    u16* kd = (u16*)(p.ws + WS_R3 + R3_KD) + (size_t)kr_ * 256;
    const float qs = 0.17677669529663687f * LOG2E;
#pragma unroll
    for (int t = 0; t < 2; ++t) {
      const int pr = lane * 2 + t, hh = pr >> 4, i = pr & 15;
      float q1 = bf2f(z[ZD + hh * 32 + i]), q2 = bf2f(z[ZD + hh * 32 + 16 + i]);
      float k1 = bf2f(z[ZD + 256 + hh * 32 + i]), k2 = bf2f(z[ZD + 256 + hh * 32 + 16 + i]);
      if (lat) {
        float2 cs = rope[i];
        float a = q1 * cs.x - q2 * cs.y, b = q1 * cs.y + q2 * cs.x; q1 = a; q2 = b;
        a = k1 * cs.x - k2 * cs.y; b = k1 * cs.y + k2 * cs.x; k1 = a; k2 = b;
      }
      qd[hh * 32 + i] = f2bf(q1 * qs); qd[hh * 32 + 16 + i] = f2bf(q2 * qs);
      kd[hh * 32 + i] = f2bf(k1); kd[hh * 32 + 16 + i] = f2bf(k2);
    }
    *(uint2*)((u16*)(p.ws + WS_R3 + R3_VD) + (size_t)kr_ * 256 + lane * 4) = *(const uint2*)(z + ZD + 512 + lane * 4);
  }
}
DI void prep_cached(const Params& p, int l, int idx) {
  const int lane = tidx() & 63;
  const int b = idx >> 8, ps = idx & 255;
  const int kr_ = TC + b * 1280 + ps;
  const size_t rb = (size_t)(b * 2 + l) * 256 + ps;
  {
    float2 v = *(const float2*)(p.in[2] + rb * 128 + lane * 2);
    *(unsigned*)((u16*)(p.ws + WS_R2 + R2_CKV) + (size_t)kr_ * 128 + lane * 2) = pk2(v.x, v.y);
  }
  if (lane < 32) {
    u16 v = f2bf(p.in[3][rb * 32 + lane]);
    u16* km = (u16*)(p.ws + WS_R2 + R2_KMLA) + (size_t)kr_ * 384;
#pragma unroll
    for (int hh = 0; hh < 4; ++hh) km[hh * 96 + 64 + lane] = v;
  }
  {
    float4 k = *(const float4*)(p.in[4] + rb * 256 + lane * 4);
    float4 v = *(const float4*)(p.in[5] + rb * 256 + lane * 4);
    uint2 o;
    o.x = pk2(k.x, k.y); o.y = pk2(k.z, k.w);
    *(uint2*)((u16*)(p.ws + WS_R3 + R3_KD) + (size_t)kr_ * 256 + lane * 4) = o;
    o.x = pk2(v.x, v.y); o.y = pk2(v.z, v.w);
    *(uint2*)((u16*)(p.ws + WS_R3 + R3_VD) + (size_t)kr_ * 256 + lane * 4) = o;
  }
}

struct MItem { int lat, b, hh, tc, nc, row0, chunk0; };
DI MItem mitem(int it) {
  MItem m;
  if (it < 256) { m.lat = 0; m.b = it >> 4; m.hh = (it >> 2) & 3; m.tc = it & 3; m.nc = 4; m.row0 = m.b * 256 + m.tc * 64; m.chunk0 = m.b * 4; }
  else { it -= 256; m.lat = 1; m.b = it >> 6; m.hh = (it >> 4) & 3; m.tc = it & 15; m.nc = 16; m.row0 = TC + m.b * 1024 + m.tc * 64; m.chunk0 = 64 + m.b * 16; }
  return m;
}
DI float logsigmoidf_(float x) { return fminf(x, 0.f) - log1pf(__expf(-fabsf(x))); }

DI void m1_item(const Params& p, int l, int it, char* smem) {
  const MItem m = mitem(it);
  const int tid = tidx(), lane = tid & 63, w = tid >> 6, r = lane & 31, h = lane >> 5;
  float* wS = (float*)smem;
  u16* KT = (u16*)(smem + 512);
  u16* VwT = KT + 64 * 72;
  const float* gates = (const float*)(p.ws + WS_R3 + R3_GATES);
  float* GB = (float*)(p.ws + WS_R3 + R3_GB);
  float* GI = (float*)(p.ws + WS_R3 + R3_GI);
  float* CHB = (float*)(p.ws + WS_R3 + R3_CHB);
  float* CHM = (float*)(p.ws + WS_R3 + R3_CHM);
  __syncthreads();
  if (w < 2) {
    const int dir = w, j = lane, tau = dir ? 63 - j : j, row = m.row0 + tau;
    const float* gb = p.in[22] + l * 16 + dir * 8;
    float ip = gates[(size_t)row * 16 + dir * 8 + m.hh] + gb[m.hh];
    float fp = gates[(size_t)row * 16 + dir * 8 + 4 + m.hh] + gb[4 + m.hh];
    float b = logsigmoidf_(fp);
#pragma unroll
    for (int d = 1; d < 64; d <<= 1) { float t = __shfl_up(b, d); if (lane >= d) b += t; }
    float bT = __shfl(b, 63);
    float a = bT - b + ip;
    float ml = wave_max(a);
    wS[dir * 64 + tau] = __expf(a - ml);
    GB[(size_t)(dir * 4 + m.hh) * T + row] = b;
    GI[(size_t)(dir * 4 + m.hh) * T + row] = ip;
    if (lane == 0) {
      const int cdir = dir ? m.nc - 1 - m.tc : m.tc;
      CHB[(dir * 4 + m.hh) * NCHUNK + m.chunk0 + cdir] = bT;
      CHM[(dir * 4 + m.hh) * NCHUNK + m.chunk0 + cdir] = ml;
    }
  }
  __syncthreads();
  const u16* Z = (const u16*)(p.ws + WS_R1 + R1_Z);
  {
    const int tau = tid & 63;
    const u16* zr = Z + (size_t)(m.row0 + tau) * ZLD + ZC + m.hh * 64;
    const float w0 = wS[tau], w1 = wS[64 + tau];
#pragma unroll
    for (int i = 0; i < 2; ++i) {
      const int dc = (tid >> 6) + 4 * i;
      uint4 kv = *(const uint4*)(zr + 256 + dc * 8);
      uint4 vv = *(const uint4*)(zr + 512 + dc * 8);
      const unsigned kk[4] = {kv.x, kv.y, kv.z, kv.w};
      const unsigned vq[4] = {vv.x, vv.y, vv.z, vv.w};
#pragma unroll
      for (int q = 0; q < 4; ++q) {
        float k0 = bf2f(kk[q] & 0xffff) * 0.125f, k1 = bf2f(kk[q] >> 16) * 0.125f;
        float v0 = bf2f(vq[q] & 0xffff), v1 = bf2f(vq[q] >> 16);
        const int d = dc * 8 + q * 2;
        KT[d * 72 + tau] = f2bf(k0); KT[(d + 1) * 72 + tau] = f2bf(k1);
        VwT[d * 72 + tau] = f2bf(v0 * w0); VwT[(d + 1) * 72 + tau] = f2bf(v1 * w0);
        VwT[64 * 72 + d * 72 + tau] = f2bf(v0 * w1); VwT[64 * 72 + (d + 1) * 72 + tau] = f2bf(v1 * w1);
      }
    }
  }
  __syncthreads();
  {
    const int dir = w >> 1, et = w & 1;
    const int cdir = dir ? m.nc - 1 - m.tc : m.tc;
    f32x16 acc[2];
    zero16(acc[0]); zero16(acc[1]);
#pragma unroll
    for (int ks = 0; ks < 4; ++ks) {
      bf16x8 a = *(const bf16x8*)(VwT + dir * 64 * 72 + (et * 32 + r) * 72 + ks * 16 + h * 8);
#pragma unroll
      for (int dt = 0; dt < 2; ++dt) {
        bf16x8 b = *(const bf16x8*)(KT + (dt * 32 + r) * 72 + ks * 16 + h * 8);
        acc[dt] = MFMA32(a, b, acc[dt]);
      }
    }
    float* DC = (float*)(p.ws + WS_R3 + R3_DC) + ((size_t)(dir * 4 + m.hh) * NCHUNK + m.chunk0 + cdir) * 4096;
#pragma unroll
    for (int dt = 0; dt < 2; ++dt)
#pragma unroll
      for (int reg = 0; reg < 16; ++reg) DC[(et * 32 + crow(reg, h)) * 64 + dt * 32 + r] = acc[dt][reg];
  }
  if (tid < 128) {
    const int dir = tid >> 6, d = tid & 63;
    const int cdir = dir ? m.nc - 1 - m.tc : m.tc;
    float s = 0.f;
    for (int tau = 0; tau < 64; ++tau) s += wS[dir * 64 + tau] * bf2f(KT[d * 72 + tau]);
    ((float*)(p.ws + WS_R3 + R3_DN))[((size_t)(dir * 4 + m.hh) * NCHUNK + m.chunk0 + cdir) * 64 + d] = s;
  }
}

DI void p3_item(const Params& p, int l, int it, char* smem) {
  const int lane = tidx() & 63, r = lane & 31, h = lane >> 5;
  f32x16 acc[2][2];
  zero_acc(acc);
  if (it < 288) {
    const int mt = it / 3, nt = it % 3, m0 = mt * 128, n0 = nt * 128;
    gemm_kloop<2, 128>((const u16*)(p.ws + WS_R2 + R2_CQ) + (size_t)m0 * 256, 256, (const u16*)(p.ws + WS_WB) + WB_UQ + (size_t)n0 * 256, 256, 256, smem, acc);
    u16* Q = (u16*)(p.ws + WS_R2 + R2_QMLA);
    const float2* rope = (const float2*)(p.ws + WS_R3 + R3_ROPE);
    const float qs = 0.10206207261596577f * LOG2E;
    epi_each<2, 128>(acc, m0, n0, [&](f32x16& a, int rbase, int cbase) {
      const bool is_rope = (cbase % 96) == 64;
      const bool lat = rbase >= TC;
#pragma unroll
      for (int reg = 0; reg < 16; ++reg) {
        const int row = rbase + crow(reg, h);
        float v = a[reg];
        if (is_rope) {
          float o = __shfl_xor(v, 16);
          if (lat) {
            float2 cs = rope[((row - TC) & 1023) * 16 + (r & 15)];
            v = (r < 16) ? (v * cs.x - o * cs.y) : (o * cs.y + v * cs.x);
          }
        }
        Q[(size_t)row * 384 + cbase + r] = f2bf(v * qs);
      }
    });
  } else {
    it -= 288;
    const int mt = it >> 2, nt = it & 3, m0 = mt * 128, n0 = nt * 128;
    gemm_kloop<2, 128>((const u16*)(p.ws + WS_R2 + R2_CKV) + (size_t)m0 * 128, 128, (const u16*)(p.ws + WS_WB) + WB_UKV + (size_t)n0 * 128, 128, 128, smem, acc);
    u16* Km = (u16*)(p.ws + WS_R2 + R2_KMLA);
    u16* Vm = (u16*)(p.ws + WS_R2 + R2_VMLA);
    epi_each<2, 128>(acc, m0, n0, [&](f32x16& a, int rbase, int cbase) {
      const int col = cbase + r, hh = col >> 7, cc = col & 127;
#pragma unroll
      for (int reg = 0; reg < 16; ++reg) {
        const int row = rbase + crow(reg, h);
        if (cc < 64) Km[(size_t)row * 384 + hh * 96 + cc] = f2bf(a[reg]);
        else Vm[(size_t)row * 256 + hh * 64 + (cc - 64)] = f2bf(a[reg]);
      }
    });
  }
}

template <int KW, int NS, class EPI>
DI void attn_item(const u16* __restrict__ Qb, int qld, const u16* __restrict__ Kb, int kld, const u16* __restrict__ Vb, int vld,
                  int nkeys, char* smem, EPI epi) {
  constexpr int DQ = KW / NS, NKS = DQ / 16, KLD = KW + 8, KCH = KW / 8, NKC = (64 * KCH) / 256;
  u16* Ks = (u16*)smem;
  u16* Vt = Ks + 64 * KLD;
  const int tid = tidx(), lane = tid & 63, w = tid >> 6, r = lane & 31, h = lane >> 5;
  bf16x8 qf[NS][NKS];
#pragma unroll
  for (int s = 0; s < NS; ++s)
#pragma unroll
    for (int ks = 0; ks < NKS; ++ks) qf[s][ks] = *(const bf16x8*)(Qb + (size_t)(w * 32 + r) * qld + s * DQ + ks * 16 + h * 8);
  f32x16 oacc[NS][2];
  float mrun[NS], lsum[NS];
#pragma unroll
  for (int s = 0; s < NS; ++s) { zero16(oacc[s][0]); zero16(oacc[s][1]); mrun[s] = -1e30f; lsum[s] = 0.f; }
  u32x4 rk[NKC], rv[2];
  auto gload = [&](int key0) {
#pragma unroll
    for (int i = 0; i < NKC; ++i) {
      const int c = tid + i * 256, key = c / KCH, kc = c % KCH;
      rk[i] = *(const u32x4*)(Kb + (size_t)(key0 + key) * kld + kc * 8);
    }
#pragma unroll
    for (int i = 0; i < 2; ++i) {
      const int key = tid & 63, ec = (tid >> 6) + 4 * i;
      rv[i] = *(const u32x4*)(Vb + (size_t)(key0 + key) * vld + ec * 8);
    }
  };
  gload(0);
  for (int key0 = 0; key0 < nkeys; key0 += 64) {
    __syncthreads();
#pragma unroll
    for (int i = 0; i < NKC; ++i) {
      const int c = tid + i * 256, key = c / KCH, kc = c % KCH;
      *(u32x4*)(Ks + key * KLD + kc * 8) = rk[i];
    }
#pragma unroll
    for (int i = 0; i < 2; ++i) {
      const int key = tid & 63, ec = (tid >> 6) + 4 * i;
      const u32x4 vv = rv[i];
#pragma unroll
      for (int q = 0; q < 4; ++q) {
        Vt[(ec * 8 + q * 2) * 72 + key] = (u16)(vv[q] & 0xffff);
        Vt[(ec * 8 + q * 2 + 1) * 72 + key] = (u16)(vv[q] >> 16);
      }
    }
    __syncthreads();
    if (key0 + 64 < nkeys) gload(key0 + 64);
#pragma unroll
    for (int s = 0; s < NS; ++s) {
      f32x16 sa[2];
      zero16(sa[0]); zero16(sa[1]);
#pragma unroll
      for (int sub = 0; sub < 2; ++sub)
#pragma unroll
        for (int ks = 0; ks < NKS; ++ks) {
          bf16x8 a = *(const bf16x8*)(Ks + (sub * 32 + r) * KLD + s * DQ + ks * 16 + h * 8);
          sa[sub] = MFMA32(a, qf[s][ks], sa[sub]);
        }
      float mx = -1e30f;
#pragma unroll
      for (int i = 0; i < 16; ++i) mx = fmaxf(mx, fmaxf(sa[0][i], sa[1][i]));
      mx = fmaxf(mx, __shfl_xor(mx, 32));
      const float mn = fmaxf(mrun[s], mx);
      const float alpha = __builtin_amdgcn_exp2f(mrun[s] - mn);
      mrun[s] = mn;
      float ps = 0.f;
#pragma unroll
      for (int sub = 0; sub < 2; ++sub)
#pragma unroll
        for (int i = 0; i < 16; ++i) { float e = __builtin_amdgcn_exp2f(sa[sub][i] - mn); sa[sub][i] = e; ps += e; }
      lsum[s] = lsum[s] * alpha + ps;
#pragma unroll
      for (int et = 0; et < 2; ++et)
#pragma unroll
        for (int i = 0; i < 16; ++i) oacc[s][et][i] *= alpha;
#pragma unroll
      for (int sub = 0; sub < 2; ++sub)
#pragma unroll
        for (int st = 0; st < 2; ++st) {
          const bf16x8 pf = pack8(sa[sub], st);
#pragma unroll
          for (int et = 0; et < 2; ++et) {
            const u16* vp = Vt + (et * 32 + r) * 72 + sub * 32 + 16 * st + 4 * h;
            s16x4 lo = *(const s16x4*)vp, hi = *(const s16x4*)(vp + 8);
            bf16x8 a = __builtin_shufflevector(lo, hi, 0, 1, 2, 3, 4, 5, 6, 7);
            oacc[s][et] = MFMA32(a, pf, oacc[s][et]);
          }
        }
    }
  }
#pragma unroll
  for (int s = 0; s < NS; ++s) {
    float lt = lsum[s] + __shfl_xor(lsum[s], 32);
    float inv = 1.f / lt;
#pragma unroll
    for (int et = 0; et < 2; ++et)
#pragma unroll
      for (int i = 0; i < 16; ++i) oacc[s][et][i] *= inv;
  }
  epi(oacc, w * 32 + r, h);
}

struct AItem { int hh, qrow0, krow0, nkeys; };
DI AItem aitem(int it) {
  AItem a;
  if (it < 256) { int b = it >> 5; a.hh = (it >> 3) & 3; int qt = it & 7; a.qrow0 = TC + b * 1024 + qt * 128; a.krow0 = TC + b * 1280; a.nkeys = 1280; }
  else { it -= 256; int b = it >> 3; a.hh = (it >> 1) & 3; int qt = it & 1; a.qrow0 = b * 256 + qt * 128; a.krow0 = b * 256; a.nkeys = 256; }
  return a;
}
DI void mla_item(const Params& p, int it, char* smem) {
  const AItem a = aitem(it);
  const u16* Q = (const u16*)(p.ws + WS_R2 + R2_QMLA) + (size_t)a.qrow0 * 384 + a.hh * 96;
  const u16* K = (const u16*)(p.ws + WS_R2 + R2_KMLA) + (size_t)a.krow0 * 384 + a.hh * 96;
  const u16* V = (const u16*)(p.ws + WS_R2 + R2_VMLA) + (size_t)a.krow0 * 256 + a.hh * 64;
  u16* Y = (u16*)(p.ws + WS_R1 + R1_YMIX);
  attn_item<96, 1>(Q, 384, K, 384, V, 256, a.nkeys, smem, [&](f32x16 (&o)[1][2], int qi, int h) {
    u16* yr = Y + (size_t)(a.qrow0 + qi) * LDH + a.hh * 64;
#pragma unroll
    for (int et = 0; et < 2; ++et)
#pragma unroll
      for (int g = 0; g < 4; ++g) {
        uint2 v;
        v.x = pk2(o[0][et][4 * g], o[0][et][4 * g + 1]);
        v.y = pk2(o[0][et][4 * g + 2], o[0][et][4 * g + 3]);
        *(uint2*)(yr + et * 32 + 8 * g + 4 * h) = v;
      }
  });
}
DI void diff_item(const Params& p, int l, int it, char* smem) {
  const AItem a = aitem(it);
  const u16* Q = (const u16*)(p.ws + WS_R3 + R3_QD) + (size_t)a.qrow0 * 256 + a.hh * 64;
  const u16* K = (const u16*)(p.ws + WS_R3 + R3_KD) + (size_t)a.krow0 * 256 + a.hh * 64;
  const u16* V = (const u16*)(p.ws + WS_R3 + R3_VD) + (size_t)a.krow0 * 256 + a.hh * 64;
  u16* Y = (u16*)(p.ws + WS_R1 + R1_YMIX);
  const float* lam = (const float*)(p.ws + WS_R3 + R3_LAM);
  const float lam_val = lam[l * 2], lam_init = lam[l * 2 + 1];
  const float* sn = p.in[25] + l * 64;
  attn_item<64, 2>(Q, 256, K, 256, V, 256, a.nkeys, smem, [&](f32x16 (&o)[2][2], int qi, int h) {
    float ss = 0.f;
#pragma unroll
    for (int et = 0; et < 2; ++et)
#pragma unroll
      for (int i = 0; i < 16; ++i) { float v = o[0][et][i] - lam_val * o[1][et][i]; o[0][et][i] = v; ss += v * v; }
    ss += __shfl_xor(ss, 32);
    const float rs = rsqrtf(ss * (1.f / 64.f) + EPS) * (1.f - lam_init);
    u16* yr = Y + (size_t)(a.qrow0 + qi) * LDH + 768 + a.hh * 64;
#pragma unroll
    for (int et = 0; et < 2; ++et)
#pragma unroll
      for (int g = 0; g < 4; ++g) {
        const int e = et * 32 + 8 * g + 4 * h;
        float4 gn = *(const float4*)(sn + e);
        uint2 v;
        v.x = pk2(o[0][et][4 * g] * rs * gn.x, o[0][et][4 * g + 1] * rs * gn.y);
        v.y = pk2(o[0][et][4 * g + 2] * rs * gn.z, o[0][et][4 * g + 3] * rs * gn.w);
        *(uint2*)(yr + e) = v;
      }
  });
}

DI void gmlp_item(const Params& p, int l, int it, char* smem) {
  const int c = it >> 2, g = it & 3;
  const int tid = tidx(), lane = tid & 63, w = tid >> 6, r = lane & 31, h = lane >> 5;
  u16* vnT = (u16*)smem;
  const u16* Z = (const u16*)(p.ws + WS_R1 + R1_Z);
  const float* rstd = (const float*)(p.ws + WS_R3 + R3_RSTDV);
  const float* vn = p.in[19] + l * 256 + g * 64;
  __syncthreads();
  {
    const int q = tid & 127, row = c * 128 + q;
    const float rs = rstd[row];
#pragma unroll
    for (int i = 0; i < 4; ++i) {
      const int dc = (tid >> 7) + 2 * i;
      uint4 v = *(const uint4*)(Z + (size_t)row * ZLD + 672 + g * 64 + dc * 8);
      const unsigned vv[4] = {v.x, v.y, v.z, v.w};
#pragma unroll
      for (int qq = 0; qq < 4; ++qq) {
        const int d = dc * 8 + qq * 2;
        vnT[d * 136 + q] = f2bf(bf2f(vv[qq] & 0xffff) * rs * vn[d]);
        vnT[(d + 1) * 136 + q] = f2bf(bf2f(vv[qq] >> 16) * rs * vn[d + 1]);
      }
    }
  }
  __syncthreads();
  const u16* Ws = (const u16*)(p.ws + WS_WB) + WB_WS + (size_t)g * 16384 + (size_t)(w * 32 + r) * 128;
  f32x16 acc[2];
  zero16(acc[0]); zero16(acc[1]);
#pragma unroll
  for (int ks = 0; ks < 8; ++ks) {
    bf16x8 b = *(const bf16x8*)(Ws + ks * 16 + h * 8);
#pragma unroll
    for (int dt = 0; dt < 2; ++dt) {
      bf16x8 a = *(const bf16x8*)(vnT + (dt * 32 + r) * 136 + ks * 16 + h * 8);
      acc[dt] = MFMA32(a, b, acc[dt]);
    }
  }
  const int pq = w * 32 + r, row = c * 128 + pq;
  const float bias = p.in[21][l * 512 + g * 128 + pq];
  const u16* zu = Z + (size_t)row * ZLD + ZB + g * 64;
  u16* yr = (u16*)(p.ws + WS_R1 + R1_YMIX) + (size_t)row * LDH + 256 + g * 64;
#pragma unroll
  for (int dt = 0; dt < 2; ++dt)
#pragma unroll
    for (int gq = 0; gq < 4; ++gq) {
      const int d = dt * 32 + 8 * gq + 4 * h;
      uint2 u = *(const uint2*)(zu + d);
      uint2 o;
      o.x = pk2(bf2f(u.x & 0xffff) * (acc[dt][4 * gq] + bias), bf2f(u.x >> 16) * (acc[dt][4 * gq + 1] + bias));
      o.y = pk2(bf2f(u.y & 0xffff) * (acc[dt][4 * gq + 2] + bias), bf2f(u.y >> 16) * (acc[dt][4 * gq + 3] + bias));
      *(uint2*)(yr + d) = o;
    }
}

DI void scan_item(const Params& p, int l, int it) {
  const int slice = it & 3, sq = it >> 2;
  const int s_ = sq % 24, dh = sq / 24, dir = dh >> 2, hh = dh & 3;
  const bool lat = s_ >= 16;
  const int b = lat ? s_ - 16 : s_, nc = lat ? 16 : 4, chunk0 = lat ? 64 + b * 16 : b * 4;
  const int tid = tidx();
  const int idx = slice * 1024 + tid * 4, e_ = idx >> 6, d0 = idx & 63;
  float* DC = (float*)(p.ws + WS_R3 + R3_DC);
  float* DN = (float*)(p.ws + WS_R3 + R3_DN);
  float* MST = (float*)(p.ws + WS_R3 + R3_MST);
  const float* CHB = (const float*)(p.ws + WS_R3 + R3_CHB);
  const float* CHM = (const float*)(p.ws + WS_R3 + R3_CHM);
  const size_t sb = (size_t)dh * NCHUNK + chunk0;
  const size_t st = ((size_t)(b * 2 + l) * 2 + dir) * 4 + hh;
  float4 C = make_float4(0.f, 0.f, 0.f, 0.f);
  float nval = 0.f, mcur = 0.f;
  const bool nthr = (slice == 0) && (tid < 64);
  if (lat) {
    const float* C0 = p.in[6] + st * 4096;
    C.x = C0[(d0 + 0) * 64 + e_]; C.y = C0[(d0 + 1) * 64 + e_]; C.z = C0[(d0 + 2) * 64 + e_]; C.w = C0[(d0 + 3) * 64 + e_];
    if (nthr) nval = p.in[7][st * 64 + tid];
    mcur = p.in[8][st];
  }
  float4 cur = *(const float4*)(DC + sb * 4096 + idx);
  float dn = nthr ? DN[sb * 64 + tid] : 0.f;
  for (int k = 0; k < nc; ++k) {
    float4 nxt = cur;
    float dnn = dn;
    if (k + 1 < nc) {
      nxt = *(const float4*)(DC + (sb + k + 1) * 4096 + idx);
      if (nthr) dnn = DN[(sb + k + 1) * 64 + tid];
    }
    *(float4*)(DC + (sb + k) * 4096 + idx) = C;
    if (nthr) DN[(sb + k) * 64 + tid] = nval;
    if (slice == 0 && tid == 0) MST[sb + k] = mcur;
    const float bT = CHB[sb + k], ml = CHM[sb + k];
    const float mn = fmaxf(bT + mcur, ml);
    const float wo = __expf(bT + mcur - mn), wn = __expf(ml - mn);
    C.x = wo * C.x + wn * cur.x; C.y = wo * C.y + wn * cur.y; C.z = wo * C.z + wn * cur.z; C.w = wo * C.w + wn * cur.w;
    nval = wo * nval + wn * dn;
    mcur = mn;
    cur = nxt; dn = dnn;
  }
  if (!lat) {
    float* oc = p.out + O_C + st * 4096;
    oc[(d0 + 0) * 64 + e_] = C.x; oc[(d0 + 1) * 64 + e_] = C.y; oc[(d0 + 2) * 64 + e_] = C.z; oc[(d0 + 3) * 64 + e_] = C.w;
    if (nthr) p.out[O_N + st * 64 + tid] = nval;
    if (slice == 0 && tid == 0) p.out[O_M + st] = mcur;
  }
}

DI void m3_item(const Params& p, int l, int it, char* smem) {
  const MItem m = mitem(it);
  const int tid = tidx(), lane = tid & 63, w = tid >> 6, r = lane & 31, h = lane >> 5;
  u16* CtS = (u16*)smem;
  u16* VT = CtS + 2 * 64 * 72;
  float* hbuf = (float*)(smem + 27648);
  float* nS = (float*)(smem + 27648 + 16384);
  float* gbS = nS + 128;
  float* giS = gbS + 128;
  const float* DC = (const float*)(p.ws + WS_R3 + R3_DC);
  const float* DN = (const float*)(p.ws + WS_R3 + R3_DN);
  const float* CHB = (const float*)(p.ws + WS_R3 + R3_CHB);
  const float* CHM = (const float*)(p.ws + WS_R3 + R3_CHM);
  const float* GB = (const float*)(p.ws + WS_R3 + R3_GB);
  const float* GI = (const float*)(p.ws + WS_R3 + R3_GI);
  const u16* Z = (const u16*)(p.ws + WS_R1 + R1_Z);
  __syncthreads();
  float mc[2];
  const int e_ = tid >> 2, d0 = (tid & 3) * 16;
  const float* MST = (const float*)(p.ws + WS_R3 + R3_MST);
#pragma unroll
  for (int dir = 0; dir < 2; ++dir) {
    const int cdir = dir ? m.nc - 1 - m.tc : m.tc;
    const size_t sb = (size_t)(dir * 4 + m.hh) * NCHUNK + m.chunk0 + cdir;
    const float* dc = DC + sb * 4096 + e_ * 64 + d0;
#pragma unroll
    for (int i = 0; i < 16; i += 4) {
      const float4 v = *(const float4*)(dc + i);
      *(unsigned*)(CtS + dir * 4608 + e_ * 72 + d0 + i) = pk2(v.x, v.y);
      *(unsigned*)(CtS + dir * 4608 + e_ * 72 + d0 + i + 2) = pk2(v.z, v.w);
    }
    if (tid < 64) nS[dir * 64 + tid] = DN[sb * 64 + tid];
    mc[dir] = MST[sb];
  }
  if (tid < 128) {
    const int dir = tid >> 6, tau = tid & 63;
    gbS[dir * 64 + tau] = GB[(size_t)(dir * 4 + m.hh) * T + m.row0 + tau];
    giS[dir * 64 + tau] = GI[(size_t)(dir * 4 + m.hh) * T + m.row0 + tau];
  }
  {
    const int tau = tid & 63;
    const u16* zr = Z + (size_t)(m.row0 + tau) * ZLD + ZC + 512 + m.hh * 64;
#pragma unroll
    for (int i = 0; i < 2; ++i) {
      const int dc = (tid >> 6) + 4 * i;
      uint4 vv = *(const uint4*)(zr + dc * 8);
      const unsigned vq[4] = {vv.x, vv.y, vv.z, vv.w};
#pragma unroll
      for (int q = 0; q < 4; ++q) {
        VT[(dc * 8 + q * 2) * 72 + tau] = (u16)(vq[q] & 0xffff);
        VT[(dc * 8 + q * 2 + 1) * 72 + tau] = (u16)(vq[q] >> 16);
      }
    }
  }
  __syncthreads();
  const int tt = w & 1, dir = w >> 1;
  const int t = tt * 32 + r;
  const float mcd = dir ? mc[1] : mc[0];
  const float* gb = gbS + dir * 64;
  const float* gi = giS + dir * 64;
  bf16x8 qf[4];
  const u16* zq = Z + (size_t)(m.row0 + t) * ZLD + ZC + m.hh * 64;
  float qn = 0.f;
#pragma unroll
  for (int ks = 0; ks < 4; ++ks) {
    qf[ks] = *(const bf16x8*)(zq + ks * 16 + h * 8);
#pragma unroll
    for (int j = 0; j < 8; ++j) qn += bf2f((u16)qf[ks][j]) * nS[dir * 64 + ks * 16 + h * 8 + j];
  }
  qn += __shfl_xor(qn, 32);
  const float bt = gb[t];
  float mxi = -1e30f;
  for (int s = 0; s < 64; ++s) {
    const bool ok = dir ? (s >= t) : (s <= t);
    const float v = gi[s] - gb[s];
    mxi = ok ? fmaxf(mxi, v) : mxi;
  }
  const float mt = fmaxf(bt + mcd, bt + mxi);
  const float w_inter = __expf(bt + mcd - mt);
  f32x16 num[2];
  zero16(num[0]); zero16(num[1]);
#pragma unroll
  for (int ks = 0; ks < 4; ++ks)
#pragma unroll
    for (int et = 0; et < 2; ++et) {
      bf16x8 a = *(const bf16x8*)(CtS + dir * 4608 + (et * 32 + r) * 72 + ks * 16 + h * 8);
      num[et] = MFMA32(a, qf[ks], num[et]);
    }
#pragma unroll
  for (int et = 0; et < 2; ++et)
#pragma unroll
    for (int i = 0; i < 16; ++i) num[et][i] *= w_inter;
  float den = 0.f;
#pragma unroll
  for (int st = 0; st < 2; ++st) {
    f32x16 sa;
    zero16(sa);
    const u16* zk = Z + (size_t)(m.row0 + st * 32 + r) * ZLD + ZC + 256 + m.hh * 64;
#pragma unroll
    for (int ks = 0; ks < 4; ++ks) {
      bf16x8 a = *(const bf16x8*)(zk + ks * 16 + h * 8);
      sa = MFMA32(a, qf[ks], sa);
    }
#pragma unroll
    for (int reg = 0; reg < 16; ++reg) {
      const int s = st * 32 + crow(reg, h);
      const bool ok = dir ? (s >= t) : (s <= t);
      const float dl = bt - gb[s] + gi[s] - mt;
      const float pv = ok ? sa[reg] * 0.125f * __expf(dl) : 0.f;
      sa[reg] = pv;
      den += pv;
    }
#pragma unroll
    for (int s2 = 0; s2 < 2; ++s2) {
      const bf16x8 pf = pack8(sa, s2);
#pragma unroll
      for (int et = 0; et < 2; ++et) {
        const u16* vp = VT + (et * 32 + r) * 72 + st * 32 + 16 * s2 + 4 * h;
        s16x4 lo = *(const s16x4*)vp, hi = *(const s16x4*)(vp + 8);
        bf16x8 a = __builtin_shufflevector(lo, hi, 0, 1, 2, 3, 4, 5, 6, 7);
        num[et] = MFMA32(a, pf, num[et]);
      }
    }
  }
  den += __shfl_xor(den, 32);
  den += w_inter * qn;
  const float dinv = 1.f / fmaxf(fabsf(den), __expf(-mt));
#pragma unroll
  for (int et = 0; et < 2; ++et)
#pragma unroll
    for (int i = 0; i < 16; ++i) num[et][i] *= dinv;
  if (dir == 1) {
#pragma unroll
    for (int et = 0; et < 2; ++et)
#pragma unroll
      for (int i = 0; i < 16; ++i) hbuf[(tt * 32 + et * 16 + i) * 64 + lane] = num[et][i];
  }
  __syncthreads();
  if (dir == 0) {
    float ss = 0.f;
#pragma unroll
    for (int et = 0; et < 2; ++et)
#pragma unroll
      for (int i = 0; i < 16; ++i) { float v = num[et][i] + hbuf[(tt * 32 + et * 16 + i) * 64 + lane]; num[et][i] = v; ss += v * v; }
    ss += __shfl_xor(ss, 32);
    const float rs = rsqrtf(ss * (1.f / 64.f) + EPS);
    const int row = m.row0 + t;
    const u16* zo = Z + (size_t)row * ZLD + ZC + 768 + m.hh * 64;
    const float* hn = p.in[23] + l * 256 + m.hh * 64;
    u16* yr = (u16*)(p.ws + WS_R1 + R1_YMIX) + (size_t)row * LDH + 512 + m.hh * 64;
#pragma unroll
    for (int et = 0; et < 2; ++et)
#pragma unroll
      for (int g = 0; g < 4; ++g) {
        const int e = et * 32 + 8 * g + 4 * h;
        uint2 ov = *(const uint2*)(zo + e);
        float4 gn = *(const float4*)(hn + e);
        uint2 o;
        o.x = pk2(sigmoidf_(bf2f(ov.x & 0xffff)) * num[et][4 * g] * rs * gn.x, sigmoidf_(bf2f(ov.x >> 16)) * num[et][4 * g + 1] * rs * gn.y);
        o.y = pk2(sigmoidf_(bf2f(ov.y & 0xffff)) * num[et][4 * g + 2] * rs * gn.z, sigmoidf_(bf2f(ov.y >> 16)) * num[et][4 * g + 3] * rs * gn.w);
        *(uint2*)(yr + e) = o;
      }
  }
}

DI u16* gate_ptr(const Params& p, int n) {
  if (n < 2) return (u16*)(p.ws + WS_R1) + (size_t)n * T * 1024;
  if (n == 2) return (u16*)(p.ws + WS_R3);
  return (u16*)(p.ws + WS_R2 + R2_G3);
}
DI void p5a_item(const Params& p, int l, int mt, int nt, char* smem, bool hn, int nmt, int nnt, bool* primed) {
  const int m0 = mt * 192, n0 = nt * 128;
  f32x16 acc[3][2];
  zero_acc(acc);
  gemm_kloop<3, 128>((const u16*)(p.ws + WS_H) + (size_t)m0 * LDH, LDH, (const u16*)(p.ws + WS_WB) + WB_MG + (size_t)n0 * LDH, LDH, 1024, smem, acc,
                     hn ? GNext{(const u16*)(p.ws + WS_H) + (size_t)nmt * 192 * LDH, (const u16*)(p.ws + WS_WB) + WB_MG + (size_t)nnt * 128 * LDH} : GNext{nullptr, nullptr}, primed);
  u16* G = gate_ptr(p, n0 >> 10);
  const float* bm = p.in[28] + (size_t)l * 4096;
  const int lane = tidx() & 63, r = lane & 31, h = lane >> 5;
  epi_each<3, 128>(acc, m0, n0, [&](f32x16& a, int rbase, int cbase) {
    const float bias = bm[cbase + r];
    const int d = (cbase & 1023) + r;
#pragma unroll
    for (int reg = 0; reg < 16; ++reg) G[(size_t)(rbase + crow(reg, h)) * 1024 + d] = f2bf(sigmoidf_(a[reg] + bias));
  });
}
DI void p5b_item(const Params& p, int mt, int nt, char* smem, bool hn, int nmt, int nnt, bool* primed) {
  const int m0 = mt * 128, n0 = nt * 64;
  const u16* Ym = (const u16*)(p.ws + WS_R1 + R1_YMIX) + (size_t)m0 * LDH;
  const u16* wb = (const u16*)(p.ws + WS_WB);
  const int lane = tidx() & 63, r = lane & 31, h = lane >> 5;
  const int w = tidx() >> 6, wm = w >> 1, wn = w & 1;
  f32x16 tot[2][1];
  zero_acc(tot);
#pragma unroll 1
  for (int n = 0; n < 4; ++n) {
    const u16* G = gate_ptr(p, n);
    uint2 gv[2][4];
#pragma unroll
    for (int i = 0; i < 2; ++i)
#pragma unroll
      for (int g = 0; g < 4; ++g)
        gv[i][g] = *(const uint2*)(G + (size_t)(m0 + wm * 64 + i * 32 + 8 * g + 4 * h + (lane & 3)) * 1024 + n0 + wn * 32 + (r & ~3));
    f32x16 ab[2][1];
    zero_acc(ab);
    GNext nx{nullptr, nullptr};
    if (n < 3) nx = GNext{Ym + (n + 1) * 256, wb + WB_BR + (size_t)((n + 1) * 1024 + n0) * 256};
    else if (hn) nx = GNext{(const u16*)(p.ws + WS_R1 + R1_YMIX) + (size_t)nmt * 128 * LDH, wb + WB_BR + (size_t)(nnt * 64) * 256};
    gemm_kloop<2, 64>(Ym + n * 256, LDH, wb + WB_BR + (size_t)(n * 1024 + n0) * 256, 256, 256, smem, ab, nx, primed);
#pragma unroll
    for (int i = 0; i < 2; ++i) {
      quad_tr(ab[i][0], lane);
#pragma unroll
      for (int g = 0; g < 4; ++g) {
        tot[i][0][4 * g] += bf2f(gv[i][g].x & 0xffff) * ab[i][0][4 * g];
        tot[i][0][4 * g + 1] += bf2f(gv[i][g].x >> 16) * ab[i][0][4 * g + 1];
        tot[i][0][4 * g + 2] += bf2f(gv[i][g].y & 0xffff) * ab[i][0][4 * g + 2];
        tot[i][0][4 * g + 3] += bf2f(gv[i][g].y >> 16) * ab[i][0][4 * g + 3];
      }
    }
  }
  u16* M = (u16*)(p.ws + WS_R2);
  epi_each<2, 64>(tot, m0, n0, [&](f32x16& a, int rbase, int cbase) {
#pragma unroll
    for (int g = 0; g < 4; ++g) {
      uint2 v;
      v.x = pk2(a[4 * g], a[4 * g + 1]); v.y = pk2(a[4 * g + 2], a[4 * g + 3]);
      *(uint2*)(M + (size_t)(rbase + 8 * g + 4 * h + (lane & 3)) * LDH + cbase + (r & ~3)) = v;
    }
  });
}

DI void p6_item(const Params& p, int mt, int nt, char* smem, bool hn, int nmt, int nnt, bool* primed) {
  const int m0 = mt * 192, n0 = nt * 128;
  f32x16 acc[3][2];
  zero_acc(acc);
  gemm_kloop<3, 128>((const u16*)(p.ws + WS_R2) + (size_t)m0 * LDH, LDH, (const u16*)(p.ws + WS_WB) + WB_OUT + (size_t)n0 * LDH, LDH, 1024, smem, acc,
                     hn ? GNext{(const u16*)(p.ws + WS_R2) + (size_t)nmt * 192 * LDH, (const u16*)(p.ws + WS_WB) + WB_OUT + (size_t)nnt * 128 * LDH} : GNext{nullptr, nullptr}, primed);
  u16* Y = (u16*)(p.ws + WS_R1);
  const int lane = tidx() & 63, r = lane & 31, h = lane >> 5;
  epi_each<3, 128>(acc, m0, n0, [&](f32x16& a, int rbase, int cbase) {
#pragma unroll
    for (int reg = 0; reg < 16; ++reg) Y[(size_t)(rbase + crow(reg, h)) * 1024 + cbase + r] = f2bf(a[reg]);
  });
}
DI void p8_item(const Params& p, int mt, int nt, char* smem, bool hn, int nmt, int nnt, bool* primed) {
  const int m0 = mt * 192, n0 = nt * 128;
  f32x16 acc[3][2];
  zero_acc(acc);
  gemm_kloop<3, 128>((const u16*)(p.ws + WS_H) + (size_t)m0 * LDH, LDH, (const u16*)(p.ws + WS_WB) + WB_FF1 + (size_t)n0 * LDH, LDH, 1024, smem, acc,
                     hn ? GNext{(const u16*)(p.ws + WS_H) + (size_t)nmt * 192 * LDH, (const u16*)(p.ws + WS_WB) + WB_FF1 + (size_t)nnt * 128 * LDH} : GNext{nullptr, nullptr}, primed);
  u16* U = (u16*)(p.ws + WS_R1);
  const int lane = tidx() & 63, r = lane & 31, h = lane >> 5;
  epi_each<3, 128>(acc, m0, n0, [&](f32x16& a, int rbase, int cbase) {
#pragma unroll
    for (int reg = 0; reg < 16; ++reg) {
      float v = fmaxf(a[reg], 0.f);
      U[(size_t)(rbase + crow(reg, h)) * LDU + cbase + r] = f2bf(v * v);
    }
  });
}
DI void p9_item(const Params& p, int mt, int nt, char* smem, bool hn, int nmt, int nnt, bool* primed) {
  const int m0 = mt * 192, n0 = nt * 128;
  f32x16 acc[3][2];
  zero_acc(acc);
  gemm_kloop<3, 128>((const u16*)(p.ws + WS_R1) + (size_t)m0 * LDU, LDU, (const u16*)(p.ws + WS_WB) + WB_FF2 + (size_t)n0 * LDU, LDU, 4096, smem, acc,
                     hn ? GNext{(const u16*)(p.ws + WS_R1) + (size_t)nmt * 192 * LDU, (const u16*)(p.ws + WS_WB) + WB_FF2 + (size_t)nnt * 128 * LDU} : GNext{nullptr, nullptr}, primed);
  u16* F = (u16*)(p.ws + WS_R2);
  const int lane = tidx() & 63, r = lane & 31, h = lane >> 5;
  epi_each<3, 128>(acc, m0, n0, [&](f32x16& a, int rbase, int cbase) {
#pragma unroll
    for (int reg = 0; reg < 16; ++reg) F[(size_t)(rbase + crow(reg, h)) * 1024 + cbase + r] = f2bf(a[reg]);
  });
}

constexpr int NPHASE = 24;
DI void run_pre(const Params& p, int ph, int bid, int nb, char* smem) {
  if (ph == 0) {
    const int n = CONV_ITEMS + 1536 + 64;
    for (int it = bid; it < n; it += nb) {
      if (it < 1536) mod_item(p, it, smem);
      else if (it < 1600) misc_item(p, it - 1536);
      else convert_item(p, 0, it - 1600, smem);
    }
  } else {
    for (int it = bid; it < T / 8; it += nb) rowwise_item(p, 0, 0, it);
  }
}
template <int S>
DI void run_lp(const Params& p, int l, int bid, int nb, char* smem) {
  if constexpr (S == 0) { bool primed = false; for_tiles(64, 22, bid, nb, [&](int mt, int nt, bool hn, int a, int b) { p1_item(p, l, mt, nt, smem, hn, a, b, &primed); }); }
  if constexpr (S == 1) {
    for (int it = bid; it < 768; it += nb) m1_item(p, l, it, smem);
    int v = (bid - 768) % nb; if (v < 0) v += nb;
    for (int it = v; it < 3072 + 512; it += nb) {
      if (it < 3072) prep_token(p, l, it * 4 + (tidx() >> 6));
      else prep_cached(p, l, (it - 3072) * 4 + (tidx() >> 6));
    }
  }
  if constexpr (S == 2) {
    for (int it = bid; it < 288 + 448; it += nb) p3_item(p, l, it, smem);
    int v = (bid - 736) % nb; if (v < 0) v += nb;
    for (int it = v; it < 768; it += nb) scan_item(p, l, it);
  }
  if constexpr (S == 3) {
    auto vb = [&](int off) { int v = (bid - off) % nb; return v < 0 ? v + nb : v; };
    for (int it = vb(0); it < 256; it += nb) mla_item(p, it, smem);
    for (int it = vb(256); it < 256; it += nb) diff_item(p, l, it, smem);
    for (int it = vb(512); it < 768; it += nb) m3_item(p, l, it, smem);
    for (int it = vb(1280); it < 384; it += nb) gmlp_item(p, l, it, smem);
    for (int it = vb(1664); it < 128; it += nb) mla_item(p, it + 256, smem);
    for (int it = vb(1792); it < 128; it += nb) diff_item(p, l, it + 256, smem);
  }
  if constexpr (S == 4) { bool primed = false; for_tiles(64, 32, bid, nb, [&](int mt, int nt, bool hn, int a, int b) { p5a_item(p, l, mt, nt, smem, hn, a, b, &primed); }); }
  if constexpr (S == 10) { bool primed = false; for_tiles(96, 16, bid, nb, [&](int mt, int nt, bool hn, int a, int b) { p5b_item(p, mt, nt, smem, hn, a, b, &primed); }); }
  if constexpr (S == 5) { bool primed = false; for_tiles(64, 8, bid, nb, [&](int mt, int nt, bool hn, int a, int b) { p6_item(p, mt, nt, smem, hn, a, b, &primed); }); }
  if constexpr (S == 6) { for (int it = bid; it < T / 8; it += nb) rowwise_item(p, l, 1, it); }
  if constexpr (S == 7) { bool primed = false; for_tiles(64, 32, bid, nb, [&](int mt, int nt, bool hn, int a, int b) { p8_item(p, mt, nt, smem, hn, a, b, &primed); }); }
  if constexpr (S == 8) { bool primed = false; for_tiles(64, 8, bid, nb, [&](int mt, int nt, bool hn, int a, int b) { p9_item(p, mt, nt, smem, hn, a, b, &primed); }); }
  if constexpr (S == 9) {
    for (int it = bid; it < T / 8; it += nb) rowwise_item(p, l, 2, it);
    if (l + 1 < 2) {
      int v = (bid - T / 8) % nb; if (v < 0) v += nb;
      for (int it = v; it < CONV_ITEMS; it += nb) convert_item(p, l + 1, it, smem);
    }
  }
}
DI void run_phase(const Params& p, int ph, int bid, int nb, char* smem) {
  if (ph < 2) { run_pre(p, ph, bid, nb, smem); return; }
  const int l = (ph - 2) / 11, s = (ph - 2) % 11;
  switch (s) {
    case 0: run_lp<0>(p, l, bid, nb, smem); break;
    case 1: run_lp<1>(p, l, bid, nb, smem); break;
    case 2: run_lp<2>(p, l, bid, nb, smem); break;
    case 3: run_lp<3>(p, l, bid, nb, smem); break;
    case 4: run_lp<4>(p, l, bid, nb, smem); break;
    case 5: run_lp<10>(p, l, bid, nb, smem); break;
    case 6: run_lp<5>(p, l, bid, nb, smem); break;
    case 7: run_lp<6>(p, l, bid, nb, smem); break;
    case 8: run_lp<7>(p, l, bid, nb, smem); break;
    case 9: run_lp<8>(p, l, bid, nb, smem); break;
    case 10: run_lp<9>(p, l, bid, nb, smem); break;
  }
}

#if MEGA
#define XB_TMO      128
#define XB_XCNT(j)  (256  + 64 * (j))
#define XB_XSUB(j)  (1280 + 64 * (j))
#define XB_XGEN(j)  (2304 + 64 * (j))
#define XB_TOP      3328
#define XB_TOPGEN   3392
#define XCD_BAR_WORDS 3456
#define XB_SPIN_CAP (1u << 18)
#define LAS __attribute__((address_space(3)))

__device__ __forceinline__ unsigned xb_ld(unsigned* p)              { return __hip_atomic_load(p, __ATOMIC_RELAXED, __HIP_MEMORY_SCOPE_AGENT); }
__device__ __forceinline__ unsigned xb_add(unsigned* p, unsigned v) { return __hip_atomic_fetch_add(p, v, __ATOMIC_RELAXED, __HIP_MEMORY_SCOPE_AGENT); }
__device__ __forceinline__ unsigned xb_xcc_id() { return (unsigned)__builtin_amdgcn_s_getreg((3 << 11) | 20) & 0xFu; }
#define XB_SPIN(cond, bar) do { unsigned _sp = 0; while (cond) { __builtin_amdgcn_s_sleep(1); \
    if ((++_sp & 255u) == 0u) { if (xb_ld(&(bar)[XB_TMO])) break; if (_sp > XB_SPIN_CAP) { atomicAdd(&(bar)[XB_TMO], 1u); break; } } } } while (0)

struct XcdBarrier {
    unsigned* bar; unsigned x;
    unsigned st[2];
};

__device__ __forceinline__ XcdBarrier xcd_barrier_post(unsigned* bar) {
    XcdBarrier b; b.bar = bar; b.x = xb_xcc_id(); b.st[0] = 0u; b.st[1] = 0u;
    if (threadIdx.x == 0) (void)xb_add(&bar[XB_XCNT(b.x)], 1u);
    return b;
}
__device__ __forceinline__ void xcd_barrier_complete(unsigned* bar, unsigned x, unsigned& nloc, unsigned& nx) {
    const unsigned G = gridDim.x * gridDim.y * gridDim.z;
    unsigned sum, cnt, mine, sp = 0u;
    for (;;) {
        sum = 0u; cnt = 0u; mine = 0u;
#pragma unroll
        for (unsigned j = 0; j < 16; ++j) { const unsigned c = xb_ld(&bar[XB_XCNT(j)]); sum += c; cnt += (c > 0u) ? 1u : 0u; mine = (j == x) ? c : mine; }
        if (sum == G) break;
        __builtin_amdgcn_s_sleep(1);
        if ((++sp & 255u) == 0u) { if (xb_ld(&bar[XB_TMO])) break; if (sp > XB_SPIN_CAP) { atomicAdd(&bar[XB_TMO], 1u); break; } }
    }
    nloc = mine > 0u ? mine : 1u; nx = cnt > 0u ? cnt : 1u;
}

__device__ __forceinline__ void xcd_barrier(XcdBarrier& b) {
    asm volatile("s_waitcnt vmcnt(0)" ::: "memory");
    __syncthreads();
    if (threadIdx.x == 0) {
        unsigned* bar = b.bar;
        __builtin_amdgcn_s_waitcnt(0);
        unsigned nloc = b.st[0], nx = b.st[1];
        if (nloc == 0u) { xcd_barrier_complete(bar, b.x, nloc, nx); b.st[0] = nloc; b.st[1] = nx; }
        const unsigned old = xb_add(&bar[XB_XSUB(b.x)], 1u);
        const unsigned gen = old / nloc;
        if (old + 1u == (gen + 1u) * nloc) {
            __builtin_amdgcn_fence(__ATOMIC_RELEASE, "agent");
            asm volatile("s_waitcnt vmcnt(0)" ::: "memory");
            const unsigned og = xb_add(&bar[XB_TOP], 1u);
            const unsigned tg = og / nx;
            if (og + 1u == (tg + 1u) * nx) xb_add(&bar[XB_TOPGEN], 1u);
            else XB_SPIN(xb_ld(&bar[XB_TOPGEN]) == tg, bar);
            __builtin_amdgcn_fence(__ATOMIC_ACQUIRE, "agent");
            xb_add(&bar[XB_XGEN(b.x)], 1u);
            asm volatile("s_waitcnt vmcnt(0)" ::: "memory");
        } else {
            XB_SPIN(xb_ld(&bar[XB_XGEN(b.x)]) == gen, bar);
            __builtin_amdgcn_fence(__ATOMIC_ACQUIRE, "agent");
            asm volatile("s_waitcnt vmcnt(0)" ::: "memory");
        }
    }
    __syncthreads();
}

__global__ void __launch_bounds__(256, 2) mega_kernel(Params p) {
  __shared__ __attribute__((aligned(16))) char smem[SMEM_BYTES];
  cg::grid_group grid = cg::this_grid();
  const int bid = blockIdx.x, nb = gridDim.x;
  XcdBarrier xb = xcd_barrier_post((unsigned*)(p.ws + WS_BAR));
  if (p.ws == nullptr) grid.sync();
  run_pre(p, 0, bid, nb, smem); xcd_barrier(xb);
  run_pre(p, 1, bid, nb, smem); xcd_barrier(xb);
#pragma unroll 1
  for (int l = 0; l < 2; ++l) {
    run_lp<0>(p, l, bid, nb, smem); xcd_barrier(xb);
    run_lp<1>(p, l, bid, nb, smem); xcd_barrier(xb);
    run_lp<2>(p, l, bid, nb, smem); xcd_barrier(xb);
    run_lp<3>(p, l, bid, nb, smem); xcd_barrier(xb);
    run_lp<4>(p, l, bid, nb, smem); xcd_barrier(xb);
    run_lp<10>(p, l, bid, nb, smem); xcd_barrier(xb);
    run_lp<5>(p, l, bid, nb, smem); xcd_barrier(xb);
    run_lp<6>(p, l, bid, nb, smem); xcd_barrier(xb);
    run_lp<7>(p, l, bid, nb, smem); xcd_barrier(xb);
    run_lp<8>(p, l, bid, nb, smem); xcd_barrier(xb);
    run_lp<9>(p, l, bid, nb, smem);
    if (l == 0) xcd_barrier(xb);
  }
}
#else
__global__ void __launch_bounds__(256, 2) phase_kernel(Params p, int ph) {
  __shared__ __attribute__((aligned(16))) char smem[SMEM_BYTES];
  run_phase(p, ph, blockIdx.x, gridDim.x, smem);
}
#endif

extern "C" void kernel_launch(void* const* d_in, const int* in_sizes, int n_in, void* d_out, int out_size, void* d_ws,
                              size_t ws_size, hipStream_t stream) {
  Params p{};
  for (int i = 0; i < 32; ++i) p.in[i] = (const float*)d_in[i];
  p.out = (float*)d_out;
  p.ws = (char*)d_ws;
  static int grid_blocks = 0;
  if (!grid_blocks) {
    int dev = 0, cus = 0, per_cu = 0;
    hipGetDevice(&dev);
    hipDeviceGetAttribute(&cus, hipDeviceAttributeMultiprocessorCount, dev);
#if MEGA
    hipOccupancyMaxActiveBlocksPerMultiprocessor(&per_cu, mega_kernel, 256, 0);
#else
    hipOccupancyMaxActiveBlocksPerMultiprocessor(&per_cu, phase_kernel, 256, 0);
#endif
    if (per_cu > 2) per_cu = 2;
    if (per_cu < 1) per_cu = 1;
    grid_blocks = cus * per_cu;
  }
  hipMemsetAsync((char*)d_ws + WS_R3 + R3_MOD, 0, (size_t)2 * 9 * 6144 * 4, stream);
#if MEGA
  hipMemsetAsync((char*)d_ws + WS_BAR, 0, BAR_BYTES, stream);
  void* args[] = {&p};
  hipError_t e = hipLaunchCooperativeKernel((void*)mega_kernel, dim3(grid_blocks), dim3(256), args, 0, stream);
  if (e != hipSuccess) fprintf(stderr, "cooperative launch failed: %s (grid %d)\n", hipGetErrorString(e), grid_blocks);
#else
  for (int ph = 0; ph < NPHASE; ++ph) {
    phase_kernel<<<grid_blocks, 256, 0, stream>>>(p, ph);
    if ((DUPMASK >> ph) & 1) phase_kernel<<<grid_blocks, 256, 0, stream>>>(p, ph);
  }
#endif
}

#ifdef ANALYZE
template <int PH> __global__ void __launch_bounds__(256, 2) an_kernel(Params p) {
  __shared__ __attribute__((aligned(16))) char smem[SMEM_BYTES];
  run_phase(p, PH, blockIdx.x, gridDim.x, smem);
}
template __global__ void an_kernel<0>(Params);
template __global__ void an_kernel<1>(Params);
template __global__ void an_kernel<2>(Params);
template __global__ void an_kernel<3>(Params);
template __global__ void an_kernel<4>(Params);
template __global__ void an_kernel<5>(Params);
template __global__ void an_kernel<6>(Params);
template __global__ void an_kernel<7>(Params);
template __global__ void an_kernel<8>(Params);
template __global__ void an_kernel<9>(Params);
template __global__ void an_kernel<10>(Params);
template __global__ void an_kernel<11>(Params);
#endif
#ifdef ANALYZE
template <int W> __global__ void __launch_bounds__(256, 2) an4_kernel(Params p) {
  __shared__ __attribute__((aligned(16))) char smem[SMEM_BYTES];
  for (int it = blockIdx.x; it < 256; it += gridDim.x) {
    if (W == 0) mla_item(p, it, smem);
    if (W == 1) diff_item(p, 0, it, smem);
    if (W == 2) m3_item(p, 0, it, smem);
    if (W == 3) gmlp_item(p, 0, it, smem);
  }
}
template __global__ void an4_kernel<0>(Params);
template __global__ void an4_kernel<1>(Params);
template __global__ void an4_kernel<2>(Params);
template __global__ void an4_kernel<3>(Params);
#endif
```

```cpp
#include <hip/hip_runtime.h>
#include <hip/hip_cooperative_groups.h>
#include <cstdio>
#include <cstdint>
namespace cg = cooperative_groups;

#ifndef MEGA
#define MEGA 1
#endif
#ifndef DUPMASK
#define DUPMASK 0u
#endif

#define DI __device__ __forceinline__
typedef unsigned short u16;
typedef __attribute__((ext_vector_type(8))) short bf16x8;
typedef __attribute__((ext_vector_type(4))) short s16x4;
typedef __attribute__((ext_vector_type(16))) float f32x16;
typedef __attribute__((ext_vector_type(2))) __bf16 bf2_t;
typedef __attribute__((ext_vector_type(4))) unsigned u32x4;
typedef __attribute__((ext_vector_type(2))) unsigned u32x2;
#define MFMA32(a, b, c) __builtin_amdgcn_mfma_f32_32x32x16_bf16((a), (b), (c), 0, 0, 0)

constexpr int D = 1024, TC = 4096, TL = 8192, T = 12288, KEYROWS = 14336;
constexpr int ZLD = 2736;
constexpr int ZB = 416, ZC = 928, ZD = 1968;
constexpr int NWIN = 2816;
constexpr int LDH = 1088, LDU = 4160;
constexpr float EPS = 1e-6f;
constexpr float LOG2E = 1.4426950408889634f;
constexpr int NCHUNK = 192;

constexpr size_t O_YP = 0, O_YS = 4194304, O_CKV = 12582912, O_KR = 13631488, O_DK = 13893632, O_DV = 15990784,
                 O_C = 18087936, O_N = 19136512, O_M = 19152896;

constexpr size_t WB_IN = 0;
constexpr size_t WB_MG = WB_IN + (size_t)NWIN * LDH;
constexpr size_t WB_UQ = WB_MG + (size_t)4096 * LDH;
constexpr size_t WB_UKV = WB_UQ + (size_t)384 * 256;
constexpr size_t WB_BR = WB_UKV + (size_t)512 * 128;
constexpr size_t WB_OUT = WB_BR + (size_t)4 * 1024 * 256;
constexpr size_t WB_FF1 = WB_OUT + (size_t)1024 * LDH;
constexpr size_t WB_FF2 = WB_FF1 + (size_t)4096 * LDH;
constexpr size_t WB_WS = WB_FF2 + (size_t)1024 * LDU;
constexpr size_t WB_TOTAL = WB_WS + (size_t)4 * 128 * 128;

constexpr size_t al256(size_t x) { return (x + 255) & ~(size_t)255; }
constexpr size_t WS_WB = 0;
constexpr size_t WS_H = al256(WS_WB + WB_TOTAL * 2);
constexpr size_t WS_R1 = al256(WS_H + (size_t)T * LDH * 2);
constexpr size_t R1_Z = 0;
constexpr size_t R1_YMIX = al256((size_t)T * ZLD * 2);
constexpr size_t R1_SIZE = (size_t)T * LDU * 2;
static_assert(R1_YMIX + (size_t)T * LDH * 2 <= R1_SIZE, "R1 overflow");
constexpr size_t WS_R2 = al256(WS_R1 + R1_SIZE);
constexpr size_t R2_CQ = 0;
constexpr size_t R2_QMLA = al256(R2_CQ + (size_t)T * 256 * 2);
constexpr size_t R2_CKV = al256(R2_QMLA + (size_t)T * 384 * 2);
constexpr size_t R2_KMLA = al256(R2_CKV + (size_t)KEYROWS * 128 * 2);
constexpr size_t R2_VMLA = al256(R2_KMLA + (size_t)KEYROWS * 384 * 2);
constexpr size_t R2_END = al256(R2_VMLA + (size_t)KEYROWS * 256 * 2);
constexpr size_t R2_G3 = al256((size_t)T * LDH * 2);
constexpr size_t R2_SIZE = R2_G3 + (size_t)T * 1024 * 2;
static_assert(R2_END <= R2_SIZE, "R2 overflow");
constexpr size_t WS_R3 = al256(WS_R2 + R2_SIZE);
constexpr size_t R3_DC = 0;
constexpr size_t R3_DN = al256(R3_DC + (size_t)2 * 4 * NCHUNK * 4096 * 4);
constexpr size_t R3_CHB = al256(R3_DN + (size_t)2 * 4 * NCHUNK * 64 * 4);
constexpr size_t R3_CHM = al256(R3_CHB + (size_t)2 * 4 * NCHUNK * 4);
constexpr size_t R3_MST = al256(R3_CHM + (size_t)2 * 4 * NCHUNK * 4);
constexpr size_t R3_GATES = al256(R3_MST + (size_t)2 * 4 * NCHUNK * 4);
constexpr size_t R3_GB = al256(R3_GATES + (size_t)T * 16 * 4);
constexpr size_t R3_GI = al256(R3_GB + (size_t)8 * T * 4);
constexpr size_t R3_RSTDV = al256(R3_GI + (size_t)8 * T * 4);
constexpr size_t R3_MOD = al256(R3_RSTDV + (size_t)T * 4);
constexpr size_t R3_BARX = al256(R3_MOD + (size_t)2 * 9 * 6144 * 4);
constexpr size_t R3_ROPE = al256(R3_BARX + 16384);
constexpr size_t R3_LAM = al256(R3_ROPE + (size_t)1024 * 16 * 8);
constexpr size_t R3_QD = al256(R3_LAM + 256);
constexpr size_t R3_KD = al256(R3_QD + (size_t)T * 256 * 2);
constexpr size_t R3_VD = al256(R3_KD + (size_t)KEYROWS * 256 * 2);
constexpr size_t R3_END = al256(R3_VD + (size_t)KEYROWS * 256 * 2);
constexpr size_t WS_BAR = WS_R3 + R3_BARX;
constexpr size_t BAR_BYTES = 16384;
constexpr size_t WS_TOTAL = WS_R3 + R3_END;
static_assert(WS_TOTAL <= (size_t)256 * 1024 * 1024, "workspace over 256 MiB");

struct Params {
  const float* in[32];
  float* out;
  char* ws;
};

constexpr int SMEM_BYTES = 2 * (192 + 128) * 128;

DI int tidx() { int t = __builtin_amdgcn_workitem_id_x(); asm volatile("" : "+v"(t)); return t; }
DI float bf2f(u16 v) { return __uint_as_float(((unsigned)v) << 16); }
DI unsigned pk2(float a, float b) { bf2_t v; v[0] = (__bf16)a; v[1] = (__bf16)b; return __builtin_bit_cast(unsigned, v); }
DI u16 f2bf(float a) { __bf16 v = (__bf16)a; return __builtin_bit_cast(u16, v); }
DI float wave_sum(float v) {
#pragma unroll
  for (int o = 32; o > 0; o >>= 1) v += __shfl_xor(v, o);
  return v;
}
DI float wave_max(float v) {
#pragma unroll
  for (int o = 32; o > 0; o >>= 1) v = fmaxf(v, __shfl_xor(v, o));
  return v;
}
DI float sigmoidf_(float x) { return 1.f / (1.f + __expf(-x)); }
DI int crow(int reg, int h) { return (reg & 3) + 8 * (reg >> 2) + 4 * h; }
DI void zero16(f32x16& a) {
#pragma unroll
  for (int i = 0; i < 16; ++i) a[i] = 0.f;
}
DI bf16x8 pack8(const f32x16& x, int s) {
  uint4 p;
  p.x = pk2(x[8 * s + 0], x[8 * s + 1]); p.y = pk2(x[8 * s + 2], x[8 * s + 3]);
  p.z = pk2(x[8 * s + 4], x[8 * s + 5]); p.w = pk2(x[8 * s + 6], x[8 * s + 7]);
  return __builtin_bit_cast(bf16x8, p);
}
DI float dpp_xor1(float v) { return __builtin_bit_cast(float, __builtin_amdgcn_update_dpp(0, __builtin_bit_cast(int, v), 0xB1, 0xF, 0xF, true)); }
DI float dpp_xor2(float v) { return __builtin_bit_cast(float, __builtin_amdgcn_update_dpp(0, __builtin_bit_cast(int, v), 0x4E, 0xF, 0xF, true)); }
DI void quad_tr(f32x16& a, int lane) {
  const bool o1 = lane & 1, o2 = lane & 2;
#pragma unroll
  for (int g = 0; g < 4; ++g) {
    float a0 = a[4 * g], a1 = a[4 * g + 1], a2 = a[4 * g + 2], a3 = a[4 * g + 3];
    float rv = dpp_xor1(o1 ? a0 : a1);
    if (o1) a0 = rv; else a1 = rv;
    rv = dpp_xor1(o1 ? a2 : a3);
    if (o1) a2 = rv; else a3 = rv;
    const float r0 = dpp_xor2(o2 ? a0 : a2), r1 = dpp_xor2(o2 ? a1 : a3);
    if (o2) { a0 = r0; a1 = r1; } else { a2 = r0; a3 = r1; }
    a[4 * g] = a0; a[4 * g + 1] = a1; a[4 * g + 2] = a2; a[4 * g + 3] = a3;
  }
}
DI int midx_of(int row) { return row < TC ? 0 : 1 + ((row - TC) >> 10); }
DI int keyrow_of(int row) { return row < TC ? row : TC + ((row - TC) >> 10) * 1280 + 256 + ((row - TC) & 1023); }

struct GNext { const u16* A; const u16* B; };
template <int TM, int BN>
DI void gemm_kloop(const u16* __restrict__ A, int lda, const u16* __restrict__ Bt, int ldb, int K, char* smem,
                   f32x16 (&acc)[TM][BN / 64], GNext nx = GNext{nullptr, nullptr}, bool* primed = nullptr) {
  constexpr int BM = 64 * TM, TN = BN / 64;
  constexpr int NA = BM / 32, NBI = BN / 32;
  constexpr int STGB = (BM + BN) * 128;
  const int tid = tidx(), lane = tid & 63, w = tid >> 6, wm = w >> 1, wn = w & 1, r = lane & 31, h = lane >> 5;
  const int gkc = ((tid & 7) ^ ((tid >> 4) & 7)) * 8;
  const u16* Ap = A + (size_t)(tid >> 3) * lda + gkc;
  const u16* Bp = Bt + (size_t)(tid >> 3) * ldb + gkc;
  const int nk = K >> 6;
  const bool hasnext = nx.A != nullptr;
  const u16* nAp = hasnext ? nx.A + (size_t)(tid >> 3) * lda + gkc : Ap;
  const u16* nBp = hasnext ? nx.B + (size_t)(tid >> 3) * ldb + gkc : Bp;
  auto issue_from = [&](const u16* ap, const u16* bp, int stg, int idx) {
    char* dst = smem + stg * STGB + tid * 16;
    if (idx < NA)
      __builtin_amdgcn_global_load_lds((const unsigned*)(ap + (size_t)(idx * 32) * lda), (__attribute__((address_space(3))) unsigned*)(dst + idx * 4096), 16, 0, 0);
    else
      __builtin_amdgcn_global_load_lds((const unsigned*)(bp + (size_t)((idx - NA) * 32) * ldb), (__attribute__((address_space(3))) unsigned*)(dst + BM * 128 + (idx - NA) * 4096), 16, 0, 0);
  };
  const int sw = (r >> 1) & 7;
  const unsigned lbase = (unsigned)(size_t)smem;
  const unsigned abase = lbase + (wm * (BM / 2) + r) * 128;
  const unsigned bbase = lbase + BM * 128 + (wn * (BN / 2) + r) * 128;
  if (!(primed && *primed)) {
    asm volatile("s_waitcnt vmcnt(0)" ::: "memory");
    __builtin_amdgcn_s_barrier();
#pragma unroll
    for (int i = 0; i < NA + NBI; ++i) issue_from(Ap, Bp, 0, i);
  }
  if (primed) *primed = hasnext;
  for (int kt = 0; kt < nk; ++kt) {
    asm volatile("s_waitcnt vmcnt(0)" ::: "memory");
    __builtin_amdgcn_s_barrier();
    const bool last = kt + 1 >= nk;
    const bool more = !last || hasnext;
    const u16* sAp = last ? nAp : Ap + (kt + 1) * 64;
    const u16* sBp = last ? nBp : Bp + (kt + 1) * 64;
    const unsigned so = (kt & 1) * STGB;
    bf16x8 af[2][2][TM], bfr[2][2][TN];
#pragma unroll
    for (int hf = 0; hf < 2; ++hf) {
#pragma unroll
      for (int kk = 0; kk < 2; ++kk) {
        const unsigned co = (((hf * 2 + kk) * 2 + h) ^ sw) * 16 + so;
#pragma unroll
        for (int i = 0; i < TM; ++i) asm volatile("ds_read_b128 %0, %1" : "=v"(af[hf][kk][i]) : "v"(abase + co + i * 4096));
#pragma unroll
        for (int j = 0; j < TN; ++j) asm volatile("ds_read_b128 %0, %1" : "=v"(bfr[hf][kk][j]) : "v"(bbase + co + j * 4096));
      }
    }
    asm volatile("s_waitcnt lgkmcnt(%0)" ::"n"(2 * (TM + TN)) : "memory");
#pragma unroll
    for (int kk = 0; kk < 2; ++kk) {
#pragma unroll
      for (int i = 0; i < TM; ++i) asm volatile("" : "+v"(af[0][kk][i]));
#pragma unroll
      for (int j = 0; j < TN; ++j) asm volatile("" : "+v"(bfr[0][kk][j]));
    }
    __builtin_amdgcn_s_setprio(1);
#pragma unroll
    for (int kk = 0; kk < 2; ++kk)
#pragma unroll
      for (int i = 0; i < TM; ++i)
#pragma unroll
        for (int j = 0; j < TN; ++j) {
          acc[i][j] = MFMA32(af[0][kk][i], bfr[0][kk][j], acc[i][j]);
          constexpr int dummy = 0; (void)dummy;
          const int m = (kk * TM + i) * TN + j;
          if (m < NA + NBI) {
            __builtin_amdgcn_sched_barrier(0);
            if (more) issue_from(sAp, sBp, (kt + 1) & 1, m);
            __builtin_amdgcn_sched_barrier(0);
          }
        }
    if (more) {
#pragma unroll
      for (int m = 2 * TM * TN; m < NA + NBI; ++m) issue_from(sAp, sBp, (kt + 1) & 1, m);
    }
    asm volatile("s_waitcnt lgkmcnt(0)" ::: "memory");
#pragma unroll
    for (int kk = 0; kk < 2; ++kk) {
#pragma unroll
      for (int i = 0; i < TM; ++i) asm volatile("" : "+v"(af[1][kk][i]));
#pragma unroll
      for (int j = 0; j < TN; ++j) asm volatile("" : "+v"(bfr[1][kk][j]));
    }
#pragma unroll
    for (int kk = 0; kk < 2; ++kk)
#pragma unroll
      for (int i = 0; i < TM; ++i)
#pragma unroll
        for (int j = 0; j < TN; ++j) acc[i][j] = MFMA32(af[1][kk][i], bfr[1][kk][j], acc[i][j]);
    __builtin_amdgcn_s_setprio(0);
  }
}

template <int TM, int BN, class F>
DI void epi_each(f32x16 (&acc)[TM][BN / 64], int m0, int n0, F f) {
  const int w = tidx() >> 6, wm = w >> 1, wn = w & 1;
#pragma unroll
  for (int i = 0; i < TM; ++i)
#pragma unroll
    for (int j = 0; j < BN / 64; ++j) f(acc[i][j], m0 + wm * (32 * TM) + i * 32, n0 + wn * (BN / 2) + j * 32);
}
template <int TM, int TN>
DI void zero_acc(f32x16 (&acc)[TM][TN]) {
#pragma unroll
  for (int i = 0; i < TM; ++i)
#pragma unroll
    for (int j = 0; j < TN; ++j) zero16(acc[i][j]);
}
template <class F>
DI void for_tiles(int NM, int NN, int bid, int nb, F f) {
  if ((nb & 7) == 0 && (NM & 7) == 0) {
    const int x = bid & 7, ns = nb >> 3, tot = (NM >> 3) * NN;
    const int nmx = NM >> 3;
    for (int j = bid >> 3; j < tot; j += ns) {
      const int jn = j + ns;
      f((j % nmx) * 8 + x, j / nmx, jn < tot, (jn % nmx) * 8 + x, jn / nmx);
    }
  } else {
    for (int it = bid; it < NM * NN; it += nb) { const int itn = it + nb; f(it / NN, it % NN, itn < NM * NN, itn / NN, itn % NN); }
  }
}

DI bool tjob(int& t, int K, int N, int Npad, int ldd, const float* __restrict__ src, u16* __restrict__ dst, char* smem) {
  const int tk = K / 64, tn = Npad / 64;
  if (t >= tk * tn) { t -= tk * tn; return false; }
  float* tile = (float*)smem;
  const int k0 = (t / tn) * 64, n0 = (t % tn) * 64;
  const int tid = tidx();
  __syncthreads();
#pragma unroll
  for (int i = 0; i < 4; ++i) {
    const int k = i * 16 + (tid >> 4), n = n0 + (tid & 15) * 4;
    float4 v = make_float4(0.f, 0.f, 0.f, 0.f);
    if (n + 3 < N) v = *(const float4*)(src + (size_t)(k0 + k) * N + n);
    else {
      if (n < N) v.x = src[(size_t)(k0 + k) * N + n];
      if (n + 1 < N) v.y = src[(size_t)(k0 + k) * N + n + 1];
      if (n + 2 < N) v.z = src[(size_t)(k0 + k) * N + n + 2];
    }
    float* tp = tile + k * 65 + (tid & 15) * 4;
    tp[0] = v.x; tp[1] = v.y; tp[2] = v.z; tp[3] = v.w;
  }
  __syncthreads();
#pragma unroll
  for (int i = 0; i < 2; ++i) {
    const int n = i * 32 + (tid >> 3), kc = (tid & 7) * 8;
    uint4 o;
    o.x = pk2(tile[(kc + 0) * 65 + n], tile[(kc + 1) * 65 + n]);
    o.y = pk2(tile[(kc + 2) * 65 + n], tile[(kc + 3) * 65 + n]);
    o.z = pk2(tile[(kc + 4) * 65 + n], tile[(kc + 5) * 65 + n]);
    o.w = pk2(tile[(kc + 6) * 65 + n], tile[(kc + 7) * 65 + n]);
    *(uint4*)(dst + (size_t)(n0 + n) * ldd + k0 + kc) = o;
  }
  return true;
}
constexpr int CONV_ITEMS = 16 * 44 + 16 * 64 + 4 * 6 + 2 * 8 + 4 * 4 * 16 + 16 * 16 + 16 * 64 + 64 * 16 + 16;
DI void convert_item(const Params& p, int l, int t, char* smem) {
  u16* wb = (u16*)(p.ws + WS_WB);
  if (tjob(t, 1024, 2736, NWIN, LDH, p.in[14] + (size_t)l * 1024 * 2736, wb + WB_IN, smem)) return;
  if (tjob(t, 1024, 4096, 4096, LDH, p.in[27] + (size_t)l * 1024 * 4096, wb + WB_MG, smem)) return;
  if (tjob(t, 256, 384, 384, 256, p.in[16] + (size_t)l * 256 * 384, wb + WB_UQ, smem)) return;
  if (tjob(t, 128, 512, 512, 128, p.in[18] + (size_t)l * 128 * 512, wb + WB_UKV, smem)) return;
#pragma unroll 1
  for (int n = 0; n < 4; ++n)
    if (tjob(t, 256, 1024, 1024, 256, p.in[26] + ((size_t)l * 4 + n) * 256 * 1024, wb + WB_BR + (size_t)n * 1024 * 256, smem)) return;
  if (tjob(t, 1024, 1024, 1024, LDH, p.in[29] + (size_t)l * 1024 * 1024, wb + WB_OUT, smem)) return;
  if (tjob(t, 1024, 4096, 4096, LDH, p.in[30] + (size_t)l * 1024 * 4096, wb + WB_FF1, smem)) return;
  if (tjob(t, 4096, 1024, 1024, LDU, p.in[31] + (size_t)l * 4096 * 1024, wb + WB_FF2, smem)) return;
  const float* src = p.in[20] + (size_t)l * 65536 + (size_t)t * 4096;
  u16* dst = wb + WB_WS + (size_t)t * 4096;
  for (int i = tidx(); i < 4096; i += 256) dst[i] = f2bf(src[i]);
}

DI void mod_item(const Params& p, int it, char* smem) {
  const int l = it / 768, rem = it % 768, cb = rem >> 3, kp = rem & 7;
  float* sc = (float*)smem;
  float* red = sc + 9 * 128;
  const int tid = tidx();
  __syncthreads();
  for (int i = tid; i < 9 * 128; i += 256) {
    int ci = i >> 7, k = kp * 128 + (i & 127);
    float x = (ci == 0) ? p.in[10][k] : p.in[9][(ci - 1) * 1024 + k];
    sc[i] = x / (1.f + __expf(-x));
  }
  __syncthreads();
  const int col = cb * 64 + (tid & 63), kg = tid >> 6;
  const float* wm = p.in[11] + (size_t)l * 1024 * 6144 + (size_t)(kp * 128) * 6144 + col;
  float acc[9];
#pragma unroll
  for (int c = 0; c < 9; ++c) acc[c] = 0.f;
#pragma unroll 8
  for (int k = kg; k < 128; k += 4) {
    float wv = wm[(size_t)k * 6144];
#pragma unroll
    for (int c = 0; c < 9; ++c) acc[c] += sc[c * 128 + k] * wv;
  }
#pragma unroll
  for (int c = 0; c < 9; ++c) red[(kg * 9 + c) * 64 + (tid & 63)] = acc[c];
  __syncthreads();
  float* mod = (float*)(p.ws + WS_R3 + R3_MOD);
  for (int i = tid; i < 9 * 64; i += 256) {
    int c = i >> 6, cc = i & 63;
    float sm = red[(0 * 9 + c) * 64 + cc] + red[(1 * 9 + c) * 64 + cc] + red[(2 * 9 + c) * 64 + cc] + red[(3 * 9 + c) * 64 + cc];
    int cg_ = cb * 64 + cc;
    if (kp == 0) sm += p.in[12][(size_t)l * 6144 + cg_];
    atomicAdd(&mod[((size_t)l * 9 + c) * 6144 + cg_], sm);
  }
}
DI void misc_item(const Params& p, int it) {
  float2* rope = (float2*)(p.ws + WS_R3 + R3_ROPE);
  int idx = it * 256 + tidx();
  int pos = idx >> 4, i = idx & 15;
  float inv = expf(-logf(10000.f) * (float)(i & 7) / 8.f);
  float ang = (float)((i < 8) ? (pos >> 6) : (pos & 63)) * inv;
  float s, c;
  sincosf(ang, &s, &c);
  rope[idx] = make_float2(c, s);
  if (it == 0 && tidx() < 2) {
    int l = tidx();
    const float* lf = p.in[24] + l * 128;
    float a = 0.f, b = 0.f;
    for (int k = 0; k < 32; ++k) { a += lf[k] * lf[32 + k]; b += lf[64 + k] * lf[96 + k]; }
    float lam_init = 0.8f - 0.6f * expf(-0.3f * (float)l);
    float* lam = (float*)(p.ws + WS_R3 + R3_LAM);
    lam[l * 2] = expf(a) - expf(b) + lam_init;
    lam[l * 2 + 1] = lam_init;
  }
}

DI void rowwise_item(const Params& p, int l, int mode, int it) {
  constexpr int NR = 2;
  const int lane = tidx() & 63, w = tidx() >> 6;
  const float* mod = (const float*)(p.ws + WS_R3 + R3_MOD);
  int row[NR], ci[NR];
  float4 xv[NR][4];
#pragma unroll
  for (int q = 0; q < NR; ++q) { row[q] = it * 8 + q * 4 + w; ci[q] = midx_of(row[q]); }
  if (mode == 0) {
#pragma unroll
    for (int q = 0; q < NR; ++q) {
      const float* src = (row[q] < TC) ? p.in[0] + (size_t)row[q] * 1024 : p.in[1] + (size_t)(row[q] - TC) * 1024;
#pragma unroll
      for (int i = 0; i < 4; ++i) xv[q][i] = *(const float4*)(src + i * 256 + lane * 4);
    }
  } else {
    const float* ng = p.in[13] + ((size_t)l * 4 + (mode == 1 ? 1 : 3)) * 1024;
    float4 yv[NR][4];
    float ss[NR];
#pragma unroll
    for (int q = 0; q < NR; ++q) {
      const u16* Y = (mode == 1) ? (const u16*)(p.ws + WS_R1) + (size_t)row[q] * 1024 : (const u16*)(p.ws + WS_R2) + (size_t)row[q] * 1024;
      const float* X = (mode == 1 && l == 0)
                           ? ((row[q] < TC) ? p.in[0] + (size_t)row[q] * 1024 : p.in[1] + (size_t)(row[q] - TC) * 1024)
                           : p.out + (size_t)row[q] * 1024;
      ss[q] = 0.f;
#pragma unroll
      for (int i = 0; i < 4; ++i) {
        const uint2 yb = *(const uint2*)(Y + i * 256 + lane * 4);
        xv[q][i] = *(const float4*)(X + i * 256 + lane * 4);
        yv[q][i] = make_float4(bf2f(yb.x & 0xffff), bf2f(yb.x >> 16), bf2f(yb.y & 0xffff), bf2f(yb.y >> 16));
        ss[q] += yv[q][i].x * yv[q][i].x + yv[q][i].y * yv[q][i].y + yv[q][i].z * yv[q][i].z + yv[q][i].w * yv[q][i].w;
      }
    }
#pragma unroll
    for (int q = 0; q < NR; ++q) ss[q] = wave_sum(ss[q]);
#pragma unroll
    for (int q = 0; q < NR; ++q) {
      const float rs = rsqrtf(ss[q] * (1.f / 1024.f) + EPS);
      const float* gm = mod + ((size_t)l * 9 + ci[q]) * 6144 + (mode == 1 ? 2048 : 5120);
#pragma unroll
      for (int i = 0; i < 4; ++i) {
        const int c = i * 256 + lane * 4;
        float4 x0 = xv[q][i];
        float4 g = *(const float4*)(ng + c);
        float4 gg = *(const float4*)(gm + c);
        x0.x += gg.x * (yv[q][i].x * rs * g.x); x0.y += gg.y * (yv[q][i].y * rs * g.y);
        x0.z += gg.z * (yv[q][i].z * rs * g.z); x0.w += gg.w * (yv[q][i].w * rs * g.w);
        xv[q][i] = x0;
      }
    }
  }
  if (mode != 0) {
#pragma unroll
    for (int q = 0; q < NR; ++q) {
      float* X = p.out + (size_t)row[q] * 1024;
#pragma unroll
      for (int i = 0; i < 4; ++i) *(float4*)(X + i * 256 + lane * 4) = xv[q][i];
    }
  }
  int ln = l, ngi = 2, off_sh = 3072, off_sc = 4096;
  if (mode == 0) { ln = 0; ngi = 0; off_sh = 0; off_sc = 1024; }
  if (mode == 2) { ln = l + 1; ngi = 0; off_sh = 0; off_sc = 1024; }
  if (ln >= 2) return;
  float s2[NR];
#pragma unroll
  for (int q = 0; q < NR; ++q) {
    s2[q] = 0.f;
#pragma unroll
    for (int i = 0; i < 4; ++i) s2[q] += xv[q][i].x * xv[q][i].x + xv[q][i].y * xv[q][i].y + xv[q][i].z * xv[q][i].z + xv[q][i].w * xv[q][i].w;
  }
#pragma unroll
  for (int q = 0; q < NR; ++q) s2[q] = wave_sum(s2[q]);
  const float* ng = p.in[13] + ((size_t)ln * 4 + ngi) * 1024;
#pragma unroll
  for (int q = 0; q < NR; ++q) {
    const float rs = rsqrtf(s2[q] * (1.f / 1024.f) + EPS);
    const float* mm = mod + ((size_t)ln * 9 + ci[q]) * 6144;
    u16* H = (u16*)(p.ws + WS_H) + (size_t)row[q] * LDH;
#pragma unroll
    for (int i = 0; i < 4; ++i) {
      const int c = i * 256 + lane * 4;
      float4 g = *(const float4*)(ng + c);
      float4 sc = *(const float4*)(mm + off_sc + c);
      float4 sh = *(const float4*)(mm + off_sh + c);
      uint2 o;
      o.x = pk2(xv[q][i].x * rs * g.x * (1.f + sc.x) + sh.x, xv[q][i].y * rs * g.y * (1.f + sc.y) + sh.y);
      o.y = pk2(xv[q][i].z * rs * g.z * (1.f + sc.z) + sh.z, xv[q][i].w * rs * g.w * (1.f + sc.w) + sh.w);
      *(uint2*)(H + c) = o;
    }
  }
}

DI void p1_item(const Params& p, int l, int mt, int nt, char* smem, bool hn, int nmt, int nnt, bool* primed) {
  const int m0 = mt * 192, n0 = nt * 128;
  const u16* H = (const u16*)(p.ws + WS_H);
  const u16* W = (const u16*)(p.ws + WS_WB) + WB_IN;
  f32x16 acc[3][2];
  zero_acc(acc);
  gemm_kloop<3, 128>(H + (size_t)m0 * LDH, LDH, W + (size_t)n0 * LDH, LDH, 1024, smem, acc,
                     hn ? GNext{H + (size_t)nmt * 192 * LDH, W + (size_t)nnt * 128 * LDH} : GNext{nullptr, nullptr}, primed);
  u16* Z = (u16*)(p.ws + WS_R1 + R1_Z);
  float* gates = (float*)(p.ws + WS_R3 + R3_GATES);
  float* out = p.out;
  const int lane = tidx() & 63, r = lane & 31, h = lane >> 5;
  epi_each<3, 128>(acc, m0, n0, [&](f32x16& a, int rbase, int cbase) {
    quad_tr(a, lane);
    const int c0 = cbase + (r & ~3);
    if (c0 >= ZLD) return;
#pragma unroll
    for (int g = 0; g < 4; ++g) {
      const int row = rbase + 8 * g + 4 * h + (lane & 3);
      const float4 v = make_float4(a[4 * g], a[4 * g + 1], a[4 * g + 2], a[4 * g + 3]);
      uint2 zb; zb.x = pk2(v.x, v.y); zb.y = pk2(v.z, v.w);
      *(uint2*)(Z + (size_t)row * ZLD + c0) = zb;
      if (c0 >= 1952 && c0 < 1968) *(float4*)(gates + (size_t)row * 16 + (c0 - 1952)) = v;
      if (row < TC) {
        const int b = row >> 8, pos = row & 255;
        const size_t rb = ((size_t)(b * 2 + l) * 256 + pos);
        if (c0 >= 384 && c0 < 416) *(float4*)(out + O_KR + rb * 32 + (c0 - 384)) = v;
        else if (c0 >= 2224 && c0 < 2480) *(float4*)(out + O_DK + rb * 256 + (c0 - 2224)) = v;
        else if (c0 >= 2480) *(float4*)(out + O_DV + rb * 256 + (c0 - 2480)) = v;
      }
    }
  });
}

DI void prep_token(const Params& p, int l, int row) {
  const int lane = tidx() & 63;
  const u16* z = (const u16*)(p.ws + WS_R1 + R1_Z) + (size_t)row * ZLD;
  const bool lat = row >= TC;
  const int pos = lat ? ((row - TC) & 1023) : 0;
  const int kr_ = keyrow_of(row);
  const float2* rope = (const float2*)(p.ws + WS_R3 + R3_ROPE) + pos * 16;
  {
    uint2 v = *(const uint2*)(z + lane * 4);
    float x0 = bf2f(v.x & 0xffff), x1 = bf2f(v.x >> 16), x2 = bf2f(v.y & 0xffff), x3 = bf2f(v.y >> 16);
    float ss = wave_sum(x0 * x0 + x1 * x1 + x2 * x2 + x3 * x3);
    float rs = rsqrtf(ss * (1.f / 256.f) + EPS);
    float4 g = *(const float4*)(p.in[15] + l * 256 + lane * 4);
    uint2 o;
    o.x = pk2(x0 * rs * g.x, x1 * rs * g.y);
    o.y = pk2(x2 * rs * g.z, x3 * rs * g.w);
    *(uint2*)((u16*)(p.ws + WS_R2 + R2_CQ) + (size_t)row * 256 + lane * 4) = o;
  }
  {
    unsigned v = *(const unsigned*)(z + 256 + lane * 2);
    float x0 = bf2f(v & 0xffff), x1 = bf2f(v >> 16);
    float ss = wave_sum(x0 * x0 + x1 * x1);
    float rs = rsqrtf(ss * (1.f / 128.f) + EPS);
    float2 g = *(const float2*)(p.in[17] + l * 128 + lane * 2);
    float y0 = x0 * rs * g.x, y1 = x1 * rs * g.y;
    *(unsigned*)((u16*)(p.ws + WS_R2 + R2_CKV) + (size_t)kr_ * 128 + lane * 2) = pk2(y0, y1);
    if (!lat) {
      const int b = row >> 8, ps = row & 255;
      *(float2*)(p.out + O_CKV + ((size_t)(b * 2 + l) * 256 + ps) * 128 + lane * 2) = make_float2(y0, y1);
    }
  }
  if (lane < 16) {
    float x1 = bf2f(z[384 + lane]), x2 = bf2f(z[400 + lane]);
    if (lat) {
      float2 cs = rope[lane];
      float a = x1 * cs.x - x2 * cs.y, b = x1 * cs.y + x2 * cs.x;
      x1 = a; x2 = b;
    }
    u16* km = (u16*)(p.ws + WS_R2 + R2_KMLA) + (size_t)kr_ * 384;
    const u16 b1 = f2bf(x1), b2 = f2bf(x2);
#pragma unroll
    for (int hh = 0; hh < 4; ++hh) { km[hh * 96 + 64 + lane] = b1; km[hh * 96 + 80 + lane] = b2; }
  }
  {
    uint2 v = *(const uint2*)(z + 672 + lane * 4);
    float x0 = bf2f(v.x & 0xffff), x1 = bf2f(v.x >> 16), x2 = bf2f(v.y & 0xffff), x3 = bf2f(v.y >> 16);
    float ss = wave_sum(x0 * x0 + x1 * x1 + x2 * x2 + x3 * x3);
    if (lane == 0) ((float*)(p.ws + WS_R3 + R3_RSTDV))[row] = rsqrtf(ss * (1.f / 256.f) + EPS);
  }
  {
    u16* qd = (u16*)(p.ws + WS_R3 + R3_QD) + (size_t)row * 256;
    u16* kd = (u16*)(p.ws + WS_R3 + R3_KD) + (size_t)kr_ * 256;
    const float qs = 0.17677669529663687f * LOG2E;
#pragma unroll
    for (int t = 0; t < 2; ++t) {
      const int pr = lane * 2 + t, hh = pr >> 4, i = pr & 15;
      float q1 = bf2f(z[ZD + hh * 32 + i]), q2 = bf2f(z[ZD + hh * 32 + 16 + i]);
      float k1 = bf2f(z[ZD + 256 + hh * 32 + i]), k2 = bf2f(z[ZD + 256 + hh * 32 + 16 + i]);
      if (lat) {
        float2 cs = rope[i];
        float a = q1 * cs.x - q2 * cs.y, b = q1 * cs.y + q2 * cs.x; q1 = a; q2 = b;
        a = k1 * cs.x - k2 * cs.y; b = k1 * cs.y + k2 * cs.x; k1 = a; k2 = b;
      }
      qd[hh * 32 + i] = f2bf(q1 * qs); qd[hh * 32 + 16 + i] = f2bf(q2 * qs);
      kd[hh * 32 + i] = f2bf(k1); kd[hh * 32 + 16 + i] = f2bf(k2);
    }
    *(uint2*)((u16*)(p.ws + WS_R3 + R3_VD) + (size_t)kr_ * 256 + lane * 4) = *(const uint2*)(z + ZD + 512 + lane * 4);
  }
}
DI void prep_cached(const Params& p, int l, int idx) {
  const int lane = tidx() & 63;
  const int b = idx >> 8, ps = idx & 255;
  const int kr_ = TC + b * 1280 + ps;
  const size_t rb = (size_t)(b * 2 + l) * 256 + ps;
  {
    float2 v = *(const float2*)(p.in[2] + rb * 128 + lane * 2);
    *(unsigned*)((u16*)(p.ws + WS_R2 + R2_CKV) + (size_t)kr_ * 128 + lane * 2) = pk2(v.x, v.y);
  }
  if (lane < 32) {
    u16 v = f2bf(p.in[3][rb * 32 + lane]);
    u16* km = (u16*)(p.ws + WS_R2 + R2_KMLA) + (size_t)kr_ * 384;
#pragma unroll
    for (int hh = 0; hh < 4; ++hh) km[hh * 96 + 64 + lane] = v;
  }
  {
    float4 k = *(const float4*)(p.in[4] + rb * 256 + lane * 4);
    float4 v = *(const float4*)(p.in[5] + rb * 256 + lane * 4);
    uint2 o;
    o.x = pk2(k.x, k.y); o.y = pk2(k.z, k.w);
    *(uint2*)((u16*)(p.ws + WS_R3 + R3_KD) + (size_t)kr_ * 256 + lane * 4) = o;
    o.x = pk2(v.x, v.y); o.y = pk2(v.z, v.w);
    *(uint2*)((u16*)(p.ws + WS_R3 + R3_VD) + (size_t)kr_ * 256 + lane * 4) = o;
  }
}

struct MItem { int lat, b, hh, tc, nc, row0, chunk0; };
DI MItem mitem(int it) {
  MItem m;
  if (it < 256) { m.lat = 0; m.b = it >> 4; m.hh = (it >> 2) & 3; m.tc = it & 3; m.nc = 4; m.row0 = m.b * 256 + m.tc * 64; m.chunk0 = m.b * 4; }
  else { it -= 256; m.lat = 1; m.b = it >> 6; m.hh = (it >> 4) & 3; m.tc = it & 15; m.nc = 16; m.row0 = TC + m.b * 1024 + m.tc * 64; m.chunk0 = 64 + m.b * 16; }
  return m;
}
DI float logsigmoidf_(float x) { return fminf(x, 0.f) - log1pf(__expf(-fabsf(x))); }

DI void m1_item(const Params& p, int l, int it, char* smem) {
  const MItem m = mitem(it);
  const int tid = tidx(), lane = tid & 63, w = tid >> 6, r = lane & 31, h = lane >> 5;
  float* wS = (float*)smem;
  u16* KT = (u16*)(smem + 512);
  u16* VwT = KT + 64 * 72;
  const float* gates = (const float*)(p.ws + WS_R3 + R3_GATES);
  float* GB = (float*)(p.ws + WS_R3 + R3_GB);
  float* GI = (float*)(p.ws + WS_R3 + R3_GI);
  float* CHB = (float*)(p.ws + WS_R3 + R3_CHB);
  float* CHM = (float*)(p.ws + WS_R3 + R3_CHM);
  __syncthreads();
  if (w < 2) {
    const int dir = w, j = lane, tau = dir ? 63 - j : j, row = m.row0 + tau;
    const float* gb = p.in[22] + l * 16 + dir * 8;
    float ip = gates[(size_t)row * 16 + dir * 8 + m.hh] + gb[m.hh];
    float fp = gates[(size_t)row * 16 + dir * 8 + 4 + m.hh] + gb[4 + m.hh];
    float b = logsigmoidf_(fp);
#pragma unroll
    for (int d = 1; d < 64; d <<= 1) { float t = __shfl_up(b, d); if (lane >= d) b += t; }
    float bT = __shfl(b, 63);
    float a = bT - b + ip;
    float ml = wave_max(a);
    wS[dir * 64 + tau] = __expf(a - ml);
    GB[(size_t)(dir * 4 + m.hh) * T + row] = b;
    GI[(size_t)(dir * 4 + m.hh) * T + row] = ip;
    if (lane == 0) {
      const int cdir = dir ? m.nc - 1 - m.tc : m.tc;
      CHB[(dir * 4 + m.hh) * NCHUNK + m.chunk0 + cdir] = bT;
      CHM[(dir * 4 + m.hh) * NCHUNK + m.chunk0 + cdir] = ml;
    }
  }
  __syncthreads();
  const u16* Z = (const u16*)(p.ws + WS_R1 + R1_Z);
  {
    const int tau = tid & 63;
    const u16* zr = Z + (size_t)(m.row0 + tau) * ZLD + ZC + m.hh * 64;
    const float w0 = wS[tau], w1 = wS[64 + tau];
#pragma unroll
    for (int i = 0; i < 2; ++i) {
      const int dc = (tid >> 6) + 4 * i;
      uint4 kv = *(const uint4*)(zr + 256 + dc * 8);
      uint4 vv = *(const uint4*)(zr + 512 + dc * 8);
      const unsigned kk[4] = {kv.x, kv.y, kv.z, kv.w};
      const unsigned vq[4] = {vv.x, vv.y, vv.z, vv.w};
#pragma unroll
      for (int q = 0; q < 4; ++q) {
        float k0 = bf2f(kk[q] & 0xffff) * 0.125f, k1 = bf2f(kk[q] >> 16) * 0.125f;
        float v0 = bf2f(vq[q] & 0xffff), v1 = bf2f(vq[q] >> 16);
        const int d = dc * 8 + q * 2;
        KT[d * 72 + tau] = f2bf(k0); KT[(d + 1) * 72 + tau] = f2bf(k1);
        VwT[d * 72 + tau] = f2bf(v0 * w0); VwT[(d + 1) * 72 + tau] = f2bf(v1 * w0);
        VwT[64 * 72 + d * 72 + tau] = f2bf(v0 * w1); VwT[64 * 72 + (d + 1) * 72 + tau] = f2bf(v1 * w1);
      }
    }
  }
  __syncthreads();
  {
    const int dir = w >> 1, et = w & 1;
    const int cdir = dir ? m.nc - 1 - m.tc : m.tc;
    f32x16 acc[2];
    zero16(acc[0]); zero16(acc[1]);
#pragma unroll
    for (int ks = 0; ks < 4; ++ks) {
      bf16x8 a = *(const bf16x8*)(VwT + dir * 64 * 72 + (et * 32 + r) * 72 + ks * 16 + h * 8);
#pragma unroll
      for (int dt = 0; dt < 2; ++dt) {
        bf16x8 b = *(const bf16x8*)(KT + (dt * 32 + r) * 72 + ks * 16 + h * 8);
        acc[dt] = MFMA32(a, b, acc[dt]);
      }
    }
    float* DC = (float*)(p.ws + WS_R3 + R3_DC) + ((size_t)(dir * 4 + m.hh) * NCHUNK + m.chunk0 + cdir) * 4096;
#pragma unroll
    for (int dt = 0; dt < 2; ++dt)
#pragma unroll
      for (int reg = 0; reg < 16; ++reg) DC[(et * 32 + crow(reg, h)) * 64 + dt * 32 + r] = acc[dt][reg];
  }
  if (tid < 128) {
    const int dir = tid >> 6, d = tid & 63;
    const int cdir = dir ? m.nc - 1 - m.tc : m.tc;
    float s = 0.f;
    for (int tau = 0; tau < 64; ++tau) s += wS[dir * 64 + tau] * bf2f(KT[d * 72 + tau]);
    ((float*)(p.ws + WS_R3 + R3_DN))[((size_t)(dir * 4 + m.hh) * NCHUNK + m.chunk0 + cdir) * 64 + d] = s;
  }
}

DI void p3_item(const Params& p, int l, int it, char* smem) {
  const int lane = tidx() & 63, r = lane & 31, h = lane >> 5;
  f32x16 acc[2][2];
  zero_acc(acc);
  if (it < 288) {
    const int mt = it / 3, nt = it % 3, m0 = mt * 128, n0 = nt * 128;
    gemm_kloop<2, 128>((const u16*)(p.ws + WS_R2 + R2_CQ) + (size_t)m0 * 256, 256, (const u16*)(p.ws + WS_WB) + WB_UQ + (size_t)n0 * 256, 256, 256, smem, acc);
    u16* Q = (u16*)(p.ws + WS_R2 + R2_QMLA);
    const float2* rope = (const float2*)(p.ws + WS_R3 + R3_ROPE);
    const float qs = 0.10206207261596577f * LOG2E;
    epi_each<2, 128>(acc, m0, n0, [&](f32x16& a, int rbase, int cbase) {
      const bool is_rope = (cbase % 96) == 64;
      const bool lat = rbase >= TC;
#pragma unroll
      for (int reg = 0; reg < 16; ++reg) {
        const int row = rbase + crow(reg, h);
        float v = a[reg];
        if (is_rope) {
          float o = __shfl_xor(v, 16);
          if (lat) {
            float2 cs = rope[((row - TC) & 1023) * 16 + (r & 15)];
            v = (r < 16) ? (v * cs.x - o * cs.y) : (o * cs.y + v * cs.x);
          }
        }
        Q[(size_t)row * 384 + cbase + r] = f2bf(v * qs);
      }
    });
  } else {
    it -= 288;
    const int mt = it >> 2, nt = it & 3, m0 = mt * 128, n0 = nt * 128;
    gemm_kloop<2, 128>((const u16*)(p.ws + WS_R2 + R2_CKV) + (size_t)m0 * 128, 128, (const u16*)(p.ws + WS_WB) + WB_UKV + (size_t)n0 * 128, 128, 128, smem, acc);
    u16* Km = (u16*)(p.ws + WS_R2 + R2_KMLA);
    u16* Vm = (u16*)(p.ws + WS_R2 + R2_VMLA);
    epi_each<2, 128>(acc, m0, n0, [&](f32x16& a, int rbase, int cbase) {
      const int col = cbase + r, hh = col >> 7, cc = col & 127;
#pragma unroll
      for (int reg = 0; reg < 16; ++reg) {
        const int row = rbase + crow(reg, h);
        if (cc < 64) Km[(size_t)row * 384 + hh * 96 + cc] = f2bf(a[reg]);
        else Vm[(size_t)row * 256 + hh * 64 + (cc - 64)] = f2bf(a[reg]);
      }
    });
  }
}

template <int KW, int NS, class EPI>
DI void attn_item(const u16* __restrict__ Qb, int qld, const u16* __restrict__ Kb, int kld, const u16* __restrict__ Vb, int vld,
                  int nkeys, char* smem, EPI epi) {
  constexpr int DQ = KW / NS, NKS = DQ / 16, KLD = KW + 8, KCH = KW / 8, NKC = (64 * KCH) / 256;
  u16* Ks = (u16*)smem;
  u16* Vt = Ks + 64 * KLD;
  const int tid = tidx(), lane = tid & 63, w = tid >> 6, r = lane & 31, h = lane >> 5;
  bf16x8 qf[NS][NKS];
#pragma unroll
  for (int s = 0; s < NS; ++s)
#pragma unroll
    for (int ks = 0; ks < NKS; ++ks) qf[s][ks] = *(const bf16x8*)(Qb + (size_t)(w * 32 + r) * qld + s * DQ + ks * 16 + h * 8);
  f32x16 oacc[NS][2];
  float mrun[NS], lsum[NS];
#pragma unroll
  for (int s = 0; s < NS; ++s) { zero16(oacc[s][0]); zero16(oacc[s][1]); mrun[s] = -1e30f; lsum[s] = 0.f; }
  u32x4 rk[NKC], rv[2];
  auto gload = [&](int key0) {
#pragma unroll
    for (int i = 0; i < NKC; ++i) {
      const int c = tid + i * 256, key = c / KCH, kc = c % KCH;
      rk[i] = *(const u32x4*)(Kb + (size_t)(key0 + key) * kld + kc * 8);
    }
#pragma unroll
    for (int i = 0; i < 2; ++i) {
      const int key = tid & 63, ec = (tid >> 6) + 4 * i;
      rv[i] = *(const u32x4*)(Vb + (size_t)(key0 + key) * vld + ec * 8);
    }
  };
  gload(0);
  for (int key0 = 0; key0 < nkeys; key0 += 64) {
    __syncthreads();
#pragma unroll
    for (int i = 0; i < NKC; ++i) {
      const int c = tid + i * 256, key = c / KCH, kc = c % KCH;
      *(u32x4*)(Ks + key * KLD + kc * 8) = rk[i];
    }
#pragma unroll
    for (int i = 0; i < 2; ++i) {
      const int key = tid & 63, ec = (tid >> 6) + 4 * i;
      const u32x4 vv = rv[i];
#pragma unroll
      for (int q = 0; q < 4; ++q) {
        Vt[(ec * 8 + q * 2) * 72 + key] = (u16)(vv[q] & 0xffff);
        Vt[(ec * 8 + q * 2 + 1) * 72 + key] = (u16)(vv[q] >> 16);
      }
    }
    __syncthreads();
    if (key0 + 64 < nkeys) gload(key0 + 64);
#pragma unroll
    for (int s = 0; s < NS; ++s) {
      f32x16 sa[2];
      zero16(sa[0]); zero16(sa[1]);
#pragma unroll
      for (int sub = 0; sub < 2; ++sub)
#pragma unroll
        for (int ks = 0; ks < NKS; ++ks) {
          bf16x8 a = *(const bf16x8*)(Ks + (sub * 32 + r) * KLD + s * DQ + ks * 16 + h * 8);
          sa[sub] = MFMA32(a, qf[s][ks], sa[sub]);
        }
      float mx = -1e30f;
#pragma unroll
      for (int i = 0; i < 16; ++i) mx = fmaxf(mx, fmaxf(sa[0][i], sa[1][i]));
      mx = fmaxf(mx, __shfl_xor(mx, 32));
      const float mn = fmaxf(mrun[s], mx);
      const float alpha = __builtin_amdgcn_exp2f(mrun[s] - mn);
      mrun[s] = mn;
      float ps = 0.f;
#pragma unroll
      for (int sub = 0; sub < 2; ++sub)
#pragma unroll
        for (int i = 0; i < 16; ++i) { float e = __builtin_amdgcn_exp2f(sa[sub][i] - mn); sa[sub][i] = e; ps += e; }
      lsum[s] = lsum[s] * alpha + ps;
#pragma unroll
      for (int et = 0; et < 2; ++et)
#pragma unroll
        for (int i = 0; i < 16; ++i) oacc[s][et][i] *= alpha;
#pragma unroll
      for (int sub = 0; sub < 2; ++sub)
#pragma unroll
        for (int st = 0; st < 2; ++st) {
          const bf16x8 pf = pack8(sa[sub], st);
#pragma unroll
          for (int et = 0; et < 2; ++et) {
            const u16* vp = Vt + (et * 32 + r) * 72 + sub * 32 + 16 * st + 4 * h;
            s16x4 lo = *(const s16x4*)vp, hi = *(const s16x4*)(vp + 8);
            bf16x8 a = __builtin_shufflevector(lo, hi, 0, 1, 2, 3, 4, 5, 6, 7);
            oacc[s][et] = MFMA32(a, pf, oacc[s][et]);
          }
        }
    }
  }
#pragma unroll
  for (int s = 0; s < NS; ++s) {
    float lt = lsum[s] + __shfl_xor(lsum[s], 32);
    float inv = 1.f / lt;
#pragma unroll
    for (int et = 0; et < 2; ++et)
#pragma unroll
      for (int i = 0; i < 16; ++i) oacc[s][et][i] *= inv;
  }
  epi(oacc, w * 32 + r, h);
}

struct AItem { int hh, qrow0, krow0, nkeys; };
DI AItem aitem(int it) {
  AItem a;
  if (it < 256) { int b = it >> 5; a.hh = (it >> 3) & 3; int qt = it & 7; a.qrow0 = TC + b * 1024 + qt * 128; a.krow0 = TC + b * 1280; a.nkeys = 1280; }
  else { it -= 256; int b = it >> 3; a.hh = (it >> 1) & 3; int qt = it & 1; a.qrow0 = b * 256 + qt * 128; a.krow0 = b * 256; a.nkeys = 256; }
  return a;
}
DI void mla_item(const Params& p, int it, char* smem) {
  const AItem a = aitem(it);
  const u16* Q = (const u16*)(p.ws + WS_R2 + R2_QMLA) + (size_t)a.qrow0 * 384 + a.hh * 96;
  const u16* K = (const u16*)(p.ws + WS_R2 + R2_KMLA) + (size_t)a.krow0 * 384 + a.hh * 96;
  const u16* V = (const u16*)(p.ws + WS_R2 + R2_VMLA) + (size_t)a.krow0 * 256 + a.hh * 64;
  u16* Y = (u16*)(p.ws + WS_R1 + R1_YMIX);
  attn_item<96, 1>(Q, 384, K, 384, V, 256, a.nkeys, smem, [&](f32x16 (&o)[1][2], int qi, int h) {
    u16* yr = Y + (size_t)(a.qrow0 + qi) * LDH + a.hh * 64;
#pragma unroll
    for (int et = 0; et < 2; ++et)
#pragma unroll
      for (int g = 0; g < 4; ++g) {
        uint2 v;
        v.x = pk2(o[0][et][4 * g], o[0][et][4 * g + 1]);
        v.y = pk2(o[0][et][4 * g + 2], o[0][et][4 * g + 3]);
        *(uint2*)(yr + et * 32 + 8 * g + 4 * h) = v;
      }
  });
}
DI void diff_item(const Params& p, int l, int it, char* smem) {
  const AItem a = aitem(it);
  const u16* Q = (const u16*)(p.ws + WS_R3 + R3_QD) + (size_t)a.qrow0 * 256 + a.hh * 64;
  const u16* K = (const u16*)(p.ws + WS_R3 + R3_KD) + (size_t)a.krow0 * 256 + a.hh * 64;
  const u16* V = (const u16*)(p.ws + WS_R3 + R3_VD) + (size_t)a.krow0 * 256 + a.hh * 64;
  u16* Y = (u16*)(p.ws + WS_R1 + R1_YMIX);
  const float* lam = (const float*)(p.ws + WS_R3 + R3_LAM);
  const float lam_val = lam[l * 2], lam_init = lam[l * 2 + 1];
  const float* sn = p.in[25] + l * 64;
  attn_item<64, 2>(Q, 256, K, 256, V, 256, a.nkeys, smem, [&](f32x16 (&o)[2][2], int qi, int h) {
    float ss = 0.f;
#pragma unroll
    for (int et = 0; et < 2; ++et)
#pragma unroll
      for (int i = 0; i < 16; ++i) { float v = o[0][et][i] - lam_val * o[1][et][i]; o[0][et][i] = v; ss += v * v; }
    ss += __shfl_xor(ss, 32);
    const float rs = rsqrtf(ss * (1.f / 64.f) + EPS) * (1.f - lam_init);
    u16* yr = Y + (size_t)(a.qrow0 + qi) * LDH + 768 + a.hh * 64;
#pragma unroll
    for (int et = 0; et < 2; ++et)
#pragma unroll
      for (int g = 0; g < 4; ++g) {
        const int e = et * 32 + 8 * g + 4 * h;
        float4 gn = *(const float4*)(sn + e);
        uint2 v;
        v.x = pk2(o[0][et][4 * g] * rs * gn.x, o[0][et][4 * g + 1] * rs * gn.y);
        v.y = pk2(o[0][et][4 * g + 2] * rs * gn.z, o[0][et][4 * g + 3] * rs * gn.w);
        *(uint2*)(yr + e) = v;
      }
  });
}

DI void gmlp_item(const Params& p, int l, int it, char* smem) {
  const int c = it >> 2, g = it & 3;
  const int tid = tidx(), lane = tid & 63, w = tid >> 6, r = lane & 31, h = lane >> 5;
  u16* vnT = (u16*)smem;
  const u16* Z = (const u16*)(p.ws + WS_R1 + R1_Z);
  const float* rstd = (const float*)(p.ws + WS_R3 + R3_RSTDV);
  const float* vn = p.in[19] + l * 256 + g * 64;
  __syncthreads();
  {
    const int q = tid & 127, row = c * 128 + q;
    const float rs = rstd[row];
#pragma unroll
    for (int i = 0; i < 4; ++i) {
      const int dc = (tid >> 7) + 2 * i;
      uint4 v = *(const uint4*)(Z + (size_t)row * ZLD + 672 + g * 64 + dc * 8);
      const unsigned vv[4] = {v.x, v.y, v.z, v.w};
#pragma unroll
      for (int qq = 0; qq < 4; ++qq) {
        const int d = dc * 8 + qq * 2;
        vnT[d * 136 + q] = f2bf(bf2f(vv[qq] & 0xffff) * rs * vn[d]);
        vnT[(d + 1) * 136 + q] = f2bf(bf2f(vv[qq] >> 16) * rs * vn[d + 1]);
      }
    }
  }
  __syncthreads();
  const u16* Ws = (const u16*)(p.ws + WS_WB) + WB_WS + (size_t)g * 16384 + (size_t)(w * 32 + r) * 128;
  f32x16 acc[2];
  zero16(acc[0]); zero16(acc[1]);
#pragma unroll
  for (int ks = 0; ks < 8; ++ks) {
    bf16x8 b = *(const bf16x8*)(Ws + ks * 16 + h * 8);
#pragma unroll
    for (int dt = 0; dt < 2; ++dt) {
      bf16x8 a = *(const bf16x8*)(vnT + (dt * 32 + r) * 136 + ks * 16 + h * 8);
      acc[dt] = MFMA32(a, b, acc[dt]);
    }
  }
  const int pq = w * 32 + r, row = c * 128 + pq;
  const float bias = p.in[21][l * 512 + g * 128 + pq];
  const u16* zu = Z + (size_t)row * ZLD + ZB + g * 64;
  u16* yr = (u16*)(p.ws + WS_R1 + R1_YMIX) + (size_t)row * LDH + 256 + g * 64;
#pragma unroll
  for (int dt = 0; dt < 2; ++dt)
#pragma unroll
    for (int gq = 0; gq < 4; ++gq) {
      const int d = dt * 32 + 8 * gq + 4 * h;
      uint2 u = *(const uint2*)(zu + d);
      uint2 o;
      o.x = pk2(bf2f(u.x & 0xffff) * (acc[dt][4 * gq] + bias), bf2f(u.x >> 16) * (acc[dt][4 * gq + 1] + bias));
      o.y = pk2(bf2f(u.y & 0xffff) * (acc[dt][4 * gq + 2] + bias), bf2f(u.y >> 16) * (acc[dt][4 * gq + 3] + bias));
      *(uint2*)(yr + d) = o;
    }
}

DI void scan_item(const Params& p, int l, int it) {
  const int slice = it & 3, sq = it >> 2;
  const int s_ = sq % 24, dh = sq / 24, dir = dh >> 2, hh = dh & 3;
  const bool lat = s_ >= 16;
  const int b = lat ? s_ - 16 : s_, nc = lat ? 16 : 4, chunk0 = lat ? 64 + b * 16 : b * 4;
  const int tid = tidx();
  const int idx = slice * 1024 + tid * 4, e_ = idx >> 6, d0 = idx & 63;
  float* DC = (float*)(p.ws + WS_R3 + R3_DC);
  float* DN = (float*)(p.ws + WS_R3 + R3_DN);
  float* MST = (float*)(p.ws + WS_R3 + R3_MST);
  const float* CHB = (const float*)(p.ws + WS_R3 + R3_CHB);
  const float* CHM = (const float*)(p.ws + WS_R3 + R3_CHM);
  const size_t sb = (size_t)dh * NCHUNK + chunk0;
  const size_t st = ((size_t)(b * 2 + l) * 2 + dir) * 4 + hh;
  float4 C = make_float4(0.f, 0.f, 0.f, 0.f);
  float nval = 0.f, mcur = 0.f;
  const bool nthr = (slice == 0) && (tid < 64);
  if (lat) {
    const float* C0 = p.in[6] + st * 4096;
    C.x = C0[(d0 + 0) * 64 + e_]; C.y = C0[(d0 + 1) * 64 + e_]; C.z = C0[(d0 + 2) * 64 + e_]; C.w = C0[(d0 + 3) * 64 + e_];
    if (nthr) nval = p.in[7][st * 64 + tid];
    mcur = p.in[8][st];
  }
  float4 cur = *(const float4*)(DC + sb * 4096 + idx);
  float dn = nthr ? DN[sb * 64 + tid] : 0.f;
  for (int k = 0; k < nc; ++k) {
    float4 nxt = cur;
    float dnn = dn;
    if (k + 1 < nc) {
      nxt = *(const float4*)(DC + (sb + k + 1) * 4096 + idx);
      if (nthr) dnn = DN[(sb + k + 1) * 64 + tid];
    }
    *(float4*)(DC + (sb + k) * 4096 + idx) = C;
    if (nthr) DN[(sb + k) * 64 + tid] = nval;
    if (slice == 0 && tid == 0) MST[sb + k] = mcur;
    const float bT = CHB[sb + k], ml = CHM[sb + k];
    const float mn = fmaxf(bT + mcur, ml);
    const float wo = __expf(bT + mcur - mn), wn = __expf(ml - mn);
    C.x = wo * C.x + wn * cur.x; C.y = wo * C.y + wn * cur.y; C.z = wo * C.z + wn * cur.z; C.w = wo * C.w + wn * cur.w;
    nval = wo * nval + wn * dn;
    mcur = mn;
    cur = nxt; dn = dnn;
  }
  if (!lat) {
    float* oc = p.out + O_C + st * 4096;
    oc[(d0 + 0) * 64 + e_] = C.x; oc[(d0 + 1) * 64 + e_] = C.y; oc[(d0 + 2) * 64 + e_] = C.z; oc[(d0 + 3) * 64 + e_] = C.w;
    if (nthr) p.out[O_N + st * 64 + tid] = nval;
    if (slice == 0 && tid == 0) p.out[O_M + st] = mcur;
  }
}

DI void m3_item(const Params& p, int l, int it, char* smem) {
  const MItem m = mitem(it);
  const int tid = tidx(), lane = tid & 63, w = tid >> 6, r = lane & 31, h = lane >> 5;
  u16* CtS = (u16*)smem;
  u16* VT = CtS + 2 * 64 * 72;
  float* hbuf = (float*)(smem + 27648);
  float* nS = (float*)(smem + 27648 + 16384);
  float* gbS = nS + 128;
  float* giS = gbS + 128;
  const float* DC = (const float*)(p.ws + WS_R3 + R3_DC);
  const float* DN = (const float*)(p.ws + WS_R3 + R3_DN);
  const float* CHB = (const float*)(p.ws + WS_R3 + R3_CHB);
  const float* CHM = (const float*)(p.ws + WS_R3 + R3_CHM);
  const float* GB = (const float*)(p.ws + WS_R3 + R3_GB);
  const float* GI = (const float*)(p.ws + WS_R3 + R3_GI);
  const u16* Z = (const u16*)(p.ws + WS_R1 + R1_Z);
  __syncthreads();
  float mc[2];
  const int e_ = tid >> 2, d0 = (tid & 3) * 16;
  const float* MST = (const float*)(p.ws + WS_R3 + R3_MST);
#pragma unroll
  for (int dir = 0; dir < 2; ++dir) {
    const int cdir = dir ? m.nc - 1 - m.tc : m.tc;
    const size_t sb = (size_t)(dir * 4 + m.hh) * NCHUNK + m.chunk0 + cdir;
    const float* dc = DC + sb * 4096 + e_ * 64 + d0;
#pragma unroll
    for (int i = 0; i < 16; i += 4) {
      const float4 v = *(const float4*)(dc + i);
      *(unsigned*)(CtS + dir * 4608 + e_ * 72 + d0 + i) = pk2(v.x, v.y);
      *(unsigned*)(CtS + dir * 4608 + e_ * 72 + d0 + i + 2) = pk2(v.z, v.w);
    }
    if (tid < 64) nS[dir * 64 + tid] = DN[sb * 64 + tid];
    mc[dir] = MST[sb];
  }
  if (tid < 128) {
    const int dir = tid >> 6, tau = tid & 63;
    gbS[dir * 64 + tau] = GB[(size_t)(dir * 4 + m.hh) * T + m.row0 + tau];
    giS[dir * 64 + tau] = GI[(size_t)(dir * 4 + m.hh) * T + m.row0 + tau];
  }
  {
    const int tau = tid & 63;
    const u16* zr = Z + (size_t)(m.row0 + tau) * ZLD + ZC + 512 + m.hh * 64;
#pragma unroll
    for (int i = 0; i < 2; ++i) {
      const int dc = (tid >> 6) + 4 * i;
      uint4 vv = *(const uint4*)(zr + dc * 8);
      const unsigned vq[4] = {vv.x, vv.y, vv.z, vv.w};
#pragma unroll
      for (int q = 0; q < 4; ++q) {
        VT[(dc * 8 + q * 2) * 72 + tau] = (u16)(vq[q] & 0xffff);
        VT[(dc * 8 + q * 2 + 1) * 72 + tau] = (u16)(vq[q] >> 16);
      }
    }
  }
  __syncthreads();
  const int tt = w & 1, dir = w >> 1;
  const int t = tt * 32 + r;
  const float mcd = dir ? mc[1] : mc[0];
  const float* gb = gbS + dir * 64;
  const float* gi = giS + dir * 64;
  bf16x8 qf[4];
  const u16* zq = Z + (size_t)(m.row0 + t) * ZLD + ZC + m.hh * 64;
  float qn = 0.f;
#pragma unroll
  for (int ks = 0; ks < 4; ++ks) {
    qf[ks] = *(const bf16x8*)(zq + ks * 16 + h * 8);
#pragma unroll
    for (int j = 0; j < 8; ++j) qn += bf2f((u16)qf[ks][j]) * nS[dir * 64 + ks * 16 + h * 8 + j];
  }
  qn += __shfl_xor(qn, 32);
  const float bt = gb[t];
  float mxi = -1e30f;
  for (int s = 0; s < 64; ++s) {
    const bool ok = dir ? (s >= t) : (s <= t);
    const float v = gi[s] - gb[s];
    mxi = ok ? fmaxf(mxi, v) : mxi;
  }
  const float mt = fmaxf(bt + mcd, bt + mxi);
  const float w_inter = __expf(bt + mcd - mt);
  f32x16 num[2];
  zero16(num[0]); zero16(num[1]);
#pragma unroll
  for (int ks = 0; ks < 4; ++ks)
#pragma unroll
    for (int et = 0; et < 2; ++et) {
      bf16x8 a = *(const bf16x8*)(CtS + dir * 4608 + (et * 32 + r) * 72 + ks * 16 + h * 8);
      num[et] = MFMA32(a, qf[ks], num[et]);
    }
#pragma unroll
  for (int et = 0; et < 2; ++et)
#pragma unroll
    for (int i = 0; i < 16; ++i) num[et][i] *= w_inter;
  float den = 0.f;
#pragma unroll
  for (int st = 0; st < 2; ++st) {
    f32x16 sa;
    zero16(sa);
    const u16* zk = Z + (size_t)(m.row0 + st * 32 + r) * ZLD + ZC + 256 + m.hh * 64;
#pragma unroll
    for (int ks = 0; ks < 4; ++ks) {
      bf16x8 a = *(const bf16x8*)(zk + ks * 16 + h * 8);
      sa = MFMA32(a, qf[ks], sa);
    }
#pragma unroll
    for (int reg = 0; reg < 16; ++reg) {
      const int s = st * 32 + crow(reg, h);
      const bool ok = dir ? (s >= t) : (s <= t);
      const float dl = bt - gb[s] + gi[s] - mt;
      const float pv = ok ? sa[reg] * 0.125f * __expf(dl) : 0.f;
      sa[reg] = pv;
      den += pv;
    }
#pragma unroll
    for (int s2 = 0; s2 < 2; ++s2) {
      const bf16x8 pf = pack8(sa, s2);
#pragma unroll
      for (int et = 0; et < 2; ++et) {
        const u16* vp = VT + (et * 32 + r) * 72 + st * 32 + 16 * s2 + 4 * h;
        s16x4 lo = *(const s16x4*)vp, hi = *(const s16x4*)(vp + 8);
        bf16x8 a = __builtin_shufflevector(lo, hi, 0, 1, 2, 3, 4, 5, 6, 7);
        num[et] = MFMA32(a, pf, num[et]);
      }
    }
  }
  den += __shfl_xor(den, 32);
  den += w_inter * qn;
  const float dinv = 1.f / fmaxf(fabsf(den), __expf(-mt));
#pragma unroll
  for (int et = 0; et < 2; ++et)
#pragma unroll
    for (int i = 0; i < 16; ++i) num[et][i] *= dinv;
  if (dir == 1) {
#pragma unroll
    for (int et = 0; et < 2; ++et)
#pragma unroll
      for (int i = 0; i < 16; ++i) hbuf[(tt * 32 + et * 16 + i) * 64 + lane] = num[et][i];
  }
  __syncthreads();
  if (dir == 0) {
    float ss = 0.f;
#pragma unroll
    for (int et = 0; et < 2; ++et)
#pragma unroll
      for (int i = 0; i < 16; ++i) { float v = num[et][i] + hbuf[(tt * 32 + et * 16 + i) * 64 + lane]; num[et][i] = v; ss += v * v; }
    ss += __shfl_xor(ss, 32);
    const float rs = rsqrtf(ss * (1.f / 64.f) + EPS);
    const int row = m.row0 + t;
    const u16* zo = Z + (size_t)row * ZLD + ZC + 768 + m.hh * 64;
    const float* hn = p.in[23] + l * 256 + m.hh * 64;
    u16* yr = (u16*)(p.ws + WS_R1 + R1_YMIX) + (size_t)row * LDH + 512 + m.hh * 64;
#pragma unroll
    for (int et = 0; et < 2; ++et)
#pragma unroll
      for (int g = 0; g < 4; ++g) {
        const int e = et * 32 + 8 * g + 4 * h;
        uint2 ov = *(const uint2*)(zo + e);
        float4 gn = *(const float4*)(hn + e);
        uint2 o;
        o.x = pk2(sigmoidf_(bf2f(ov.x & 0xffff)) * num[et][4 * g] * rs * gn.x, sigmoidf_(bf2f(ov.x >> 16)) * num[et][4 * g + 1] * rs * gn.y);
        o.y = pk2(sigmoidf_(bf2f(ov.y & 0xffff)) * num[et][4 * g + 2] * rs * gn.z, sigmoidf_(bf2f(ov.y >> 16)) * num[et][4 * g + 3] * rs * gn.w);
        *(uint2*)(yr + e) = o;
      }
  }
}

DI u16* gate_ptr(const Params& p, int n) {
  if (n < 2) return (u16*)(p.ws + WS_R1) + (size_t)n * T * 1024;
  if (n == 2) return (u16*)(p.ws + WS_R3);
  return (u16*)(p.ws + WS_R2 + R2_G3);
}
DI void p5a_item(const Params& p, int l, int mt, int nt, char* smem, bool hn, int nmt, int nnt, bool* primed) {
  const int m0 = mt * 192, n0 = nt * 128;
  f32x16 acc[3][2];
  zero_acc(acc);
  gemm_kloop<3, 128>((const u16*)(p.ws + WS_H) + (size_t)m0 * LDH, LDH, (const u16*)(p.ws + WS_WB) + WB_MG + (size_t)n0 * LDH, LDH, 1024, smem, acc,
                     hn ? GNext{(const u16*)(p.ws + WS_H) + (size_t)nmt * 192 * LDH, (const u16*)(p.ws + WS_WB) + WB_MG + (size_t)nnt * 128 * LDH} : GNext{nullptr, nullptr}, primed);
  u16* G = gate_ptr(p, n0 >> 10);
  const float* bm = p.in[28] + (size_t)l * 4096;
  const int lane = tidx() & 63, r = lane & 31, h = lane >> 5;
  epi_each<3, 128>(acc, m0, n0, [&](f32x16& a, int rbase, int cbase) {
    const float bias = bm[cbase + r];
    const int d = (cbase & 1023) + r;
#pragma unroll
    for (int reg = 0; reg < 16; ++reg) G[(size_t)(rbase + crow(reg, h)) * 1024 + d] = f2bf(sigmoidf_(a[reg] + bias));
  });
}
DI void p5b_item(const Params& p, int mt, int nt, char* smem, bool hn, int nmt, int nnt, bool* primed) {
  const int m0 = mt * 128, n0 = nt * 64;
  const u16* Ym = (const u16*)(p.ws + WS_R1 + R1_YMIX) + (size_t)m0 * LDH;
  const u16* wb = (const u16*)(p.ws + WS_WB);
  const int lane = tidx() & 63, r = lane & 31, h = lane >> 5;
  const int w = tidx() >> 6, wm = w >> 1, wn = w & 1;
  f32x16 tot[2][1];
  zero_acc(tot);
#pragma unroll 1
  for (int n = 0; n < 4; ++n) {
    const u16* G = gate_ptr(p, n);
    uint2 gv[2][4];
#pragma unroll
    for (int i = 0; i < 2; ++i)
#pragma unroll
      for (int g = 0; g < 4; ++g)
        gv[i][g] = *(const uint2*)(G + (size_t)(m0 + wm * 64 + i * 32 + 8 * g + 4 * h + (lane & 3)) * 1024 + n0 + wn * 32 + (r & ~3));
    f32x16 ab[2][1];
    zero_acc(ab);
    GNext nx{nullptr, nullptr};
    if (n < 3) nx = GNext{Ym + (n + 1) * 256, wb + WB_BR + (size_t)((n + 1) * 1024 + n0) * 256};
    else if (hn) nx = GNext{(const u16*)(p.ws + WS_R1 + R1_YMIX) + (size_t)nmt * 128 * LDH, wb + WB_BR + (size_t)(nnt * 64) * 256};
    gemm_kloop<2, 64>(Ym + n * 256, LDH, wb + WB_BR + (size_t)(n * 1024 + n0) * 256, 256, 256, smem, ab, nx, primed);
#pragma unroll
    for (int i = 0; i < 2; ++i) {
      quad_tr(ab[i][0], lane);
#pragma unroll
      for (int g = 0; g < 4; ++g) {
        tot[i][0][4 * g] += bf2f(gv[i][g].x & 0xffff) * ab[i][0][4 * g];
        tot[i][0][4 * g + 1] += bf2f(gv[i][g].x >> 16) * ab[i][0][4 * g + 1];
        tot[i][0][4 * g + 2] += bf2f(gv[i][g].y & 0xffff) * ab[i][0][4 * g + 2];
        tot[i][0][4 * g + 3] += bf2f(gv[i][g].y >> 16) * ab[i][0][4 * g + 3];
      }
    }
  }
  u16* M = (u16*)(p.ws + WS_R2);
  epi_each<2, 64>(tot, m0, n0, [&](f32x16& a, int rbase, int cbase) {
#pragma unroll
    for (int g = 0; g < 4; ++g) {
      uint2 v;
      v.x = pk2(a[4 * g], a[4 * g + 1]); v.y = pk2(a[4 * g + 2], a[4 * g + 3]);
      *(uint2*)(M + (size_t)(rbase + 8 * g + 4 * h + (lane & 3)) * LDH + cbase + (r & ~3)) = v;
    }
  });
}

DI void p6_item(const Params& p, int mt, int nt, char* smem, bool hn, int nmt, int nnt, bool* primed) {
  const int m0 = mt * 192, n0 = nt * 128;
  f32x16 acc[3][2];
  zero_acc(acc);
  gemm_kloop<3, 128>((const u16*)(p.ws + WS_R2) + (size_t)m0 * LDH, LDH, (const u16*)(p.ws + WS_WB) + WB_OUT + (size_t)n0 * LDH, LDH, 1024, smem, acc,
                     hn ? GNext{(const u16*)(p.ws + WS_R2) + (size_t)nmt * 192 * LDH, (const u16*)(p.ws + WS_WB) + WB_OUT + (size_t)nnt * 128 * LDH} : GNext{nullptr, nullptr}, primed);
  u16* Y = (u16*)(p.ws + WS_R1);
  const int lane = tidx() & 63, r = lane & 31, h = lane >> 5;
  epi_each<3, 128>(acc, m0, n0, [&](f32x16& a, int rbase, int cbase) {
#pragma unroll
    for (int reg = 0; reg < 16; ++reg) Y[(size_t)(rbase + crow(reg, h)) * 1024 + cbase + r] = f2bf(a[reg]);
  });
}
DI void p8_item(const Params& p, int mt, int nt, char* smem, bool hn, int nmt, int nnt, bool* primed) {
  const int m0 = mt * 192, n0 = nt * 128;
  f32x16 acc[3][2];
  zero_acc(acc);
  gemm_kloop<3, 128>((const u16*)(p.ws + WS_H) + (size_t)m0 * LDH, LDH, (const u16*)(p.ws + WS_WB) + WB_FF1 + (size_t)n0 * LDH, LDH, 1024, smem, acc,
                     hn ? GNext{(const u16*)(p.ws + WS_H) + (size_t)nmt * 192 * LDH, (const u16*)(p.ws + WS_WB) + WB_FF1 + (size_t)nnt * 128 * LDH} : GNext{nullptr, nullptr}, primed);
  u16* U = (u16*)(p.ws + WS_R1);
  const int lane = tidx() & 63, r = lane & 31, h = lane >> 5;
  epi_each<3, 128>(acc, m0, n0, [&](f32x16& a, int rbase, int cbase) {
#pragma unroll
    for (int reg = 0; reg < 16; ++reg) {
      float v = fmaxf(a[reg], 0.f);
      U[(size_t)(rbase + crow(reg, h)) * LDU + cbase + r] = f2bf(v * v);
    }
  });
}
DI void p9_item(const Params& p, int mt, int nt, char* smem, bool hn, int nmt, int nnt, bool* primed) {
  const int m0 = mt * 192, n0 = nt * 128;
  f32x16 acc[3][2];
  zero_acc(acc);
  gemm_kloop<3, 128>((const u16*)(p.ws + WS_R1) + (size_t)m0 * LDU, LDU, (const u16*)(p.ws + WS_WB) + WB_FF2 + (size_t)n0 * LDU, LDU, 4096, smem, acc,
                     hn ? GNext{(const u16*)(p.ws + WS_R1) + (size_t)nmt * 192 * LDU, (const u16*)(p.ws + WS_WB) + WB_FF2 + (size_t)nnt * 128 * LDU} : GNext{nullptr, nullptr}, primed);
  u16* F = (u16*)(p.ws + WS_R2);
  const int lane = tidx() & 63, r = lane & 31, h = lane >> 5;
  epi_each<3, 128>(acc, m0, n0, [&](f32x16& a, int rbase, int cbase) {
#pragma unroll
    for (int reg = 0; reg < 16; ++reg) F[(size_t)(rbase + crow(reg, h)) * 1024 + cbase + r] = f2bf(a[reg]);
  });
}

constexpr int NPHASE = 24;
DI void run_pre(const Params& p, int ph, int bid, int nb, char* smem) {
  if (ph == 0) {
    const int n = CONV_ITEMS + 1536 + 64;
    for (int it = bid; it < n; it += nb) {
      if (it < 1536) mod_item(p, it, smem);
      else if (it < 1600) misc_item(p, it - 1536);
      else convert_item(p, 0, it - 1600, smem);
    }
  } else {
    for (int it = bid; it < T / 8; it += nb) rowwise_item(p, 0, 0, it);
  }
}
template <int S>
DI void run_lp(const Params& p, int l, int bid, int nb, char* smem) {
  if constexpr (S == 0) { bool primed = false; for_tiles(64, 22, bid, nb, [&](int mt, int nt, bool hn, int a, int b) { p1_item(p, l, mt, nt, smem, hn, a, b, &primed); }); }
  if constexpr (S == 1) {
    for (int it = bid; it < 768; it += nb) m1_item(p, l, it, smem);
    int v = (bid - 768) % nb; if (v < 0) v += nb;
    for (int it = v; it < 3072 + 512; it += nb) {
      if (it < 3072) prep_token(p, l, it * 4 + (tidx() >> 6));
      else prep_cached(p, l, (it - 3072) * 4 + (tidx() >> 6));
    }
  }
  if constexpr (S == 2) {
    for (int it = bid; it < 288 + 448; it += nb) p3_item(p, l, it, smem);
    int v = (bid - 736) % nb; if (v < 0) v += nb;
    for (int it = v; it < 768; it += nb) scan_item(p, l, it);
  }
  if constexpr (S == 3) {
    auto vb = [&](int off) { int v = (bid - off) % nb; return v < 0 ? v + nb : v; };
    for (int it = vb(0); it < 256; it += nb) mla_item(p, it, smem);
    for (int it = vb(256); it < 256; it += nb) diff_item(p, l, it, smem);
    for (int it = vb(512); it < 768; it += nb) m3_item(p, l, it, smem);
    for (int it = vb(1280); it < 384; it += nb) gmlp_item(p, l, it, smem);
    for (int it = vb(1664); it < 128; it += nb) mla_item(p, it + 256, smem);
    for (int it = vb(1792); it < 128; it += nb) diff_item(p, l, it + 256, smem);
  }
  if constexpr (S == 4) { bool primed = false; for_tiles(64, 32, bid, nb, [&](int mt, int nt, bool hn, int a, int b) { p5a_item(p, l, mt, nt, smem, hn, a, b, &primed); }); }
  if constexpr (S == 10) { bool primed = false; for_tiles(96, 16, bid, nb, [&](int mt, int nt, bool hn, int a, int b) { p5b_item(p, mt, nt, smem, hn, a, b, &primed); }); }
  if constexpr (S == 5) { bool primed = false; for_tiles(64, 8, bid, nb, [&](int mt, int nt, bool hn, int a, int b) { p6_item(p, mt, nt, smem, hn, a, b, &primed); }); }
  if constexpr (S == 6) { for (int it = bid; it < T / 8; it += nb) rowwise_item(p, l, 1, it); }
  if constexpr (S == 7) { bool primed = false; for_tiles(64, 32, bid, nb, [&](int mt, int nt, bool hn, int a, int b) { p8_item(p, mt, nt, smem, hn, a, b, &primed); }); }
  if constexpr (S == 8) { bool primed = false; for_tiles(64, 8, bid, nb, [&](int mt, int nt, bool hn, int a, int b) { p9_item(p, mt, nt, smem, hn, a, b, &primed); }); }
  if constexpr (S == 9) {
    for (int it = bid; it < T / 8; it += nb) rowwise_item(p, l, 2, it);
    if (l + 1 < 2) {
      int v = (bid - T / 8) % nb; if (v < 0) v += nb;
      for (int it = v; it < CONV_ITEMS; it += nb) convert_item(p, l + 1, it, smem);
    }
  }
}
DI void run_phase(const Params& p, int ph, int bid, int nb, char* smem) {
  if (ph < 2) { run_pre(p, ph, bid, nb, smem); return; }
  const int l = (ph - 2) / 11, s = (ph - 2) % 11;
  switch (s) {
    case 0: run_lp<0>(p, l, bid, nb, smem); break;
    case 1: run_lp<1>(p, l, bid, nb, smem); break;
    case 2: run_lp<2>(p, l, bid, nb, smem); break;
    case 3: run_lp<3>(p, l, bid, nb, smem); break;
    case 4: run_lp<4>(p, l, bid, nb, smem); break;
    case 5: run_lp<10>(p, l, bid, nb, smem); break;
    case 6: run_lp<5>(p, l, bid, nb, smem); break;
    case 7: run_lp<6>(p, l, bid, nb, smem); break;
    case 8: run_lp<7>(p, l, bid, nb, smem); break;
    case 9: run_lp<8>(p, l, bid, nb, smem); break;
    case 10: run_lp<9>(p, l, bid, nb, smem); break;
  }
}

#if MEGA
#define XB_TMO      128
#define XB_XCNT(j)  (256  + 64 * (j))
#define XB_XSUB(j)  (1280 + 64 * (j))
#define XB_XGEN(j)  (2304 + 64 * (j))
#define XB_TOP      3328
#define XB_TOPGEN   3392
#define XCD_BAR_WORDS 3456
#define XB_SPIN_CAP (1u << 18)
#define LAS __attribute__((address_space(3)))

__device__ __forceinline__ unsigned xb_ld(unsigned* p)              { return __hip_atomic_load(p, __ATOMIC_RELAXED, __HIP_MEMORY_SCOPE_AGENT); }
__device__ __forceinline__ unsigned xb_add(unsigned* p, unsigned v) { return __hip_atomic_fetch_add(p, v, __ATOMIC_RELAXED, __HIP_MEMORY_SCOPE_AGENT); }
__device__ __forceinline__ unsigned xb_xcc_id() { return (unsigned)__builtin_amdgcn_s_getreg((3 << 11) | 20) & 0xFu; }
#define XB_SPIN(cond, bar) do { unsigned _sp = 0; while (cond) { __builtin_amdgcn_s_sleep(1); \
    if ((++_sp & 255u) == 0u) { if (xb_ld(&(bar)[XB_TMO])) break; if (_sp > XB_SPIN_CAP) { atomicAdd(&(bar)[XB_TMO], 1u); break; } } } } while (0)

struct XcdBarrier {
    unsigned* bar; unsigned x;
    unsigned st[2];
};

__device__ __forceinline__ XcdBarrier xcd_barrier_post(unsigned* bar) {
    XcdBarrier b; b.bar = bar; b.x = xb_xcc_id(); b.st[0] = 0u; b.st[1] = 0u;
    if (threadIdx.x == 0) (void)xb_add(&bar[XB_XCNT(b.x)], 1u);
    return b;
}
__device__ __forceinline__ void xcd_barrier_complete(unsigned* bar, unsigned x, unsigned& nloc, unsigned& nx) {
    const unsigned G = gridDim.x * gridDim.y * gridDim.z;
    unsigned sum, cnt, mine, sp = 0u;
    for (;;) {
        sum = 0u; cnt = 0u; mine = 0u;
#pragma unroll
        for (unsigned j = 0; j < 16; ++j) { const unsigned c = xb_ld(&bar[XB_XCNT(j)]); sum += c; cnt += (c > 0u) ? 1u : 0u; mine = (j == x) ? c : mine; }
        if (sum == G) break;
        __builtin_amdgcn_s_sleep(1);
        if ((++sp & 255u) == 0u) { if (xb_ld(&bar[XB_TMO])) break; if (sp > XB_SPIN_CAP) { atomicAdd(&bar[XB_TMO], 1u); break; } }
    }
    nloc = mine > 0u ? mine : 1u; nx = cnt > 0u ? cnt : 1u;
}

__device__ __forceinline__ void xcd_barrier(XcdBarrier& b) {
    asm volatile("s_waitcnt vmcnt(0)" ::: "memory");
    __syncthreads();
    if (threadIdx.x == 0) {
        unsigned* bar = b.bar;
        __builtin_amdgcn_s_waitcnt(0);
        unsigned nloc = b.st[0], nx = b.st[1];
        if (nloc == 0u) { xcd_barrier_complete(bar, b.x, nloc, nx); b.st[0] = nloc; b.st[1] = nx; }
        const unsigned old = xb_add(&bar[XB_XSUB(b.x)], 1u);
        const unsigned gen = old / nloc;
        if (old + 1u == (gen + 1u) * nloc) {
            __builtin_amdgcn_fence(__ATOMIC_RELEASE, "agent");
            asm volatile("s_waitcnt vmcnt(0)" ::: "memory");
            const unsigned og = xb_add(&bar[XB_TOP], 1u);
            const unsigned tg = og / nx;
            if (og + 1u == (tg + 1u) * nx) xb_add(&bar[XB_TOPGEN], 1u);
            else XB_SPIN(xb_ld(&bar[XB_TOPGEN]) == tg, bar);
            __builtin_amdgcn_fence(__ATOMIC_ACQUIRE, "agent");
            xb_add(&bar[XB_XGEN(b.x)], 1u);
            asm volatile("s_waitcnt vmcnt(0)" ::: "memory");
        } else {
            XB_SPIN(xb_ld(&bar[XB_XGEN(b.x)]) == gen, bar);
            __builtin_amdgcn_fence(__ATOMIC_ACQUIRE, "agent");
            asm volatile("s_waitcnt vmcnt(0)" ::: "memory");
        }
    }
    __syncthreads();
}

__global__ void __launch_bounds__(256, 2) mega_kernel(Params p) {
  __shared__ __attribute__((aligned(16))) char smem[SMEM_BYTES];
  cg::grid_group grid = cg::this_grid();
  const int bid = blockIdx.x, nb = gridDim.x;
  XcdBarrier xb = xcd_barrier_post((unsigned*)(p.ws + WS_BAR));
  if (p.ws == nullptr) grid.sync();
  run_pre(p, 0, bid, nb, smem); xcd_barrier(xb);
  run_pre(p, 1, bid, nb, smem); xcd_barrier(xb);
#pragma unroll 1
  for (int l = 0; l < 2; ++l) {
    run_lp<0>(p, l, bid, nb, smem); xcd_barrier(xb);
    run_lp<1>(p, l, bid, nb, smem); xcd_barrier(xb);
    run_lp<2>(p, l, bid, nb, smem); xcd_barrier(xb);
    run_lp<3>(p, l, bid, nb, smem); xcd_barrier(xb);
    run_lp<4>(p, l, bid, nb, smem); xcd_barrier(xb);
    run_lp<10>(p, l, bid, nb, smem); xcd_barrier(xb);
    run_lp<5>(p, l, bid, nb, smem); xcd_barrier(xb);
    run_lp<6>(p, l, bid, nb, smem); xcd_barrier(xb);
    run_lp<7>(p, l, bid, nb, smem); xcd_barrier(xb);
    run_lp<8>(p, l, bid, nb, smem); xcd_barrier(xb);
    run_lp<9>(p, l, bid, nb, smem);
    if (l == 0) xcd_barrier(xb);
  }
}
#else
__global__ void __launch_bounds__(256, 2) phase_kernel(Params p, int ph) {
  __shared__ __attribute__((aligned(16))) char smem[SMEM_BYTES];
  run_phase(p, ph, blockIdx.x, gridDim.x, smem);
}
#endif

extern "C" void kernel_launch(void* const* d_in, const int* in_sizes, int n_in, void* d_out, int out_size, void* d_ws,
                              size_t ws_size, hipStream_t stream) {
  Params p{};
  for (int i = 0; i < 32; ++i) p.in[i] = (const float*)d_in[i];
  p.out = (float*)d_out;
  p.ws = (char*)d_ws;
  static int grid_blocks = 0;
  if (!grid_blocks) {
    int dev = 0, cus = 0, per_cu = 0;
    hipGetDevice(&dev);
    hipDeviceGetAttribute(&cus, hipDeviceAttributeMultiprocessorCount, dev);
#if MEGA
    hipOccupancyMaxActiveBlocksPerMultiprocessor(&per_cu, mega_kernel, 256, 0);
#else
    hipOccupancyMaxActiveBlocksPerMultiprocessor(&per_cu, phase_kernel, 256, 0);
#endif
    if (per_cu > 2) per_cu = 2;
    if (per_cu < 1) per_cu = 1;
    grid_blocks = cus * per_cu;
  }
  hipMemsetAsync((char*)d_ws + WS_R3 + R3_MOD, 0, (R3_BARX - R3_MOD) + BAR_BYTES, stream);
#if MEGA
  void* args[] = {&p};
  hipError_t e = hipLaunchCooperativeKernel((void*)mega_kernel, dim3(grid_blocks), dim3(256), args, 0, stream);
  if (e != hipSuccess) fprintf(stderr, "cooperative launch failed: %s (grid %d)\n", hipGetErrorString(e), grid_blocks);
#else
  for (int ph = 0; ph < NPHASE; ++ph) {
    phase_kernel<<<grid_blocks, 256, 0, stream>>>(p, ph);
    if ((DUPMASK >> ph) & 1) phase_kernel<<<grid_blocks, 256, 0, stream>>>(p, ph);
  }
#endif
}

#ifdef ANALYZE
template <int PH> __global__ void __launch_bounds__(256, 2) an_kernel(Params p) {
  __shared__ __attribute__((aligned(16))) char smem[SMEM_BYTES];
  run_phase(p, PH, blockIdx.x, gridDim.x, smem);
}
template __global__ void an_kernel<0>(Params);
template __global__ void an_kernel<1>(Params);
template __global__ void an_kernel<2>(Params);
template __global__ void an_kernel<3>(Params);
template __global__ void an_kernel<4>(Params);
template __global__ void an_kernel<5>(Params);
template __global__ void an_kernel<6>(Params);
template __global__ void an_kernel<7>(Params);
template __global__ void an_kernel<8>(Params);
template __global__ void an_kernel<9>(Params);
template __global__ void an_kernel<10>(Params);
template __global__ void an_kernel<11>(Params);
#endif
#ifdef ANALYZE
template <int W> __global__ void __launch_bounds__(256, 2) an4_kernel(Params p) {
  __shared__ __attribute__((aligned(16))) char smem[SMEM_BYTES];
  for (int it = blockIdx.x; it < 256; it += gridDim.x) {
    if (W == 0) mla_item(p, it, smem);
    if (W == 1) diff_item(p, 0, it, smem);
    if (W == 2) m3_item(p, 0, it, smem);
    if (W == 3) gmlp_item(p, 0, it, smem);
  }
}
template __global__ void an4_kernel<0>(Params);
template __global__ void an4_kernel<1>(Params);
template __global__ void an4_kernel<2>(Params);
template __global__ void an4_kernel<3>(Params);
#endif
```
